# Optimizing an MI355X kernel written in HIP

```python
import math
import jax, jax.numpy as jnp
from jax import lax
import numpy as np

D_MODEL = 1024
BATCH = 4
SEQ = 8192
DEPTH = 2

HEAD_DIM = 64
A_HEADS = 8
A_BRANCHES = ((128, 1), (512, 4), (2048, 16))
A_BLOCK = 64
B_HEADS = 8
B_KV_HEADS = 2
B_QBLOCK = 128
GRID_W = 64
ROPE_THETA = 10000.0
C_HEADS = 16
C_KV_HEADS = 4
C_RADIUS = 128
C_BLOCK = 128
NUM_BUCKETS = 32
MAX_EXACT = 8
MAX_DISTANCE = 1024
BIAS_HEADS = 16
N_EXPERTS = 16
D_EXPERT = 2048
CAPACITY_FACTOR = 2
EPS = 1e-6
NEG_INF = -1e30
A_W = A_HEADS * HEAD_DIM
B_QW = B_HEADS * HEAD_DIM
B_KVW = B_KV_HEADS * HEAD_DIM
C_QW = C_HEADS * HEAD_DIM
C_KVW = C_KV_HEADS * HEAD_DIM
L0_IN = 3 * A_W + B_QW + 2 * B_KVW
L0_OUT = A_W + B_QW
L1_IN = C_QW + 2 * C_KVW

kernel_name = 'hybrid_dilated_axial_window_ec_encoder'


def rms_norm(x, g):
    xf = x.astype(jnp.float32)
    y = xf * lax.rsqrt(jnp.mean(xf * xf, axis=-1, keepdims=True) + EPS)
    return (y * g.astype(jnp.float32)).astype(x.dtype)


def t5_bucket(rel):
    half = NUM_BUCKETS // 2
    ret = jnp.where(rel > 0, half, 0)
    n = jnp.abs(rel)
    nf = jnp.maximum(n, 1).astype(jnp.float32)
    large = MAX_EXACT + (jnp.log(nf / MAX_EXACT) / math.log(MAX_DISTANCE / MAX_EXACT)
                         * (half - MAX_EXACT)).astype(jnp.int32)
    large = jnp.minimum(large, half - 1)
    return ret + jnp.where(n < MAX_EXACT, n, large)


def local_offsets(block):
    return jnp.arange(3 * block)[None, :] - block - jnp.arange(block)[:, None]


def split_heads(t, n):
    b, s, _ = t.shape
    return t.reshape(b, s, n, HEAD_DIM).transpose(0, 2, 1, 3)


def band_attention(q, k, v, radius, block, bias, sink):
    b, hq, length, hd = q.shape
    hkv = k.shape[1]
    g = hq // hkv
    nb = -(-length // block)
    lp = nb * block
    qp = jnp.pad(q, ((0, 0), (0, 0), (0, lp - length), (0, 0))).reshape(b, hkv, g, nb, block, hd)
    kv_pad = ((0, 0), (0, 0), (block, lp - length + block), (0, 0))

    def windows(t):
        tb = jnp.pad(t, kv_pad).reshape(b, hkv, nb + 2, block, hd)
        return jnp.concatenate([tb[:, :, :-2], tb[:, :, 1:-1], tb[:, :, 2:]], axis=3)

    kw = windows(k)
    vw = windows(v)
    s = jnp.einsum('bhgnqd,bhnkd->bhgnqk', qp, kw).astype(jnp.float32) / math.sqrt(hd)
    s = s + bias.astype(jnp.float32).reshape(hkv, g, 1, block, 3 * block)
    rel = local_offsets(block)
    kpos = jnp.arange(nb)[:, None] * block - block + jnp.arange(3 * block)[None, :]
    valid = (jnp.abs(rel) <= radius)[None] & ((kpos >= 0) & (kpos < length))[:, None, :]
    s = jnp.where(valid, s, NEG_INF)
    m = jnp.max(s, axis=-1)
    if sink is not None:
        sk = sink.astype(jnp.float32).reshape(hkv, g, 1, 1)
        m = jnp.maximum(m, sk)
    p = jnp.exp(s - m[..., None])
    l = jnp.sum(p, axis=-1)
    if sink is not None:
        l = l + jnp.exp(sk - m)
    o = jnp.einsum('bhgnqk,bhnkd->bhgnqd', (p / l[..., None]).astype(v.dtype), vw)
    o = o.reshape(b, hq, lp, hd)[:, :, :length]
    return o, m.reshape(b, hq, lp)[:, :, :length], l.reshape(b, hq, lp)[:, :, :length]


def dilated_attention(q, k, v, rel_bias):
    b, h, s, hd = q.shape
    rel = local_offsets(A_BLOCK)
    outs, ms, ls = [], [], []
    for window, dil in A_BRANCHES:
        radius = window // (2 * dil)
        ls_len = s // dil

        def to_sub(t):
            return t.reshape(b, h, ls_len, dil, hd).transpose(0, 3, 1, 2, 4).reshape(b * dil, h, ls_len, hd)

        bias = rel_bias[:A_HEADS][:, t5_bucket(rel * dil)]
        o, m, l = band_attention(to_sub(q), to_sub(k), to_sub(v), radius, A_BLOCK, bias, None)
        outs.append(o.reshape(b, dil, h, ls_len, hd).transpose(0, 2, 3, 1, 4).reshape(b, h, s, hd))
        ms.append(m.reshape(b, dil, h, ls_len).transpose(0, 2, 3, 1).reshape(b, h, s))
        ls.append(l.reshape(b, dil, h, ls_len).transpose(0, 2, 3, 1).reshape(b, h, s))
    m_all = jnp.stack(ms)
    w = jnp.exp(m_all - jnp.max(m_all, axis=0, keepdims=True)) * jnp.stack(ls)
    o_all = jnp.stack(outs).astype(jnp.float32)
    out = jnp.sum(w[..., None] * o_all, axis=0) / jnp.sum(w, axis=0)[..., None]
    return out.astype(q.dtype)


def axial_rope(x):
    s = x.shape[2]
    rows = s // GRID_W
    row = jnp.broadcast_to(jnp.arange(rows)[:, None], (rows, GRID_W)).reshape(s)
    col = jnp.broadcast_to(jnp.arange(GRID_W)[None, :], (rows, GRID_W)).reshape(s)
    half = HEAD_DIM // 2
    inv = ROPE_THETA ** (-jnp.arange(0, half, 2, dtype=jnp.float32) / half)

    def rot(xh, pos):
        ang = pos.astype(jnp.float32)[:, None] * inv
        cos, sin = jnp.cos(ang), jnp.sin(ang)
        x1, x2 = jnp.split(xh.astype(jnp.float32), 2, axis=-1)
        return jnp.concatenate([x1 * cos - x2 * sin, x1 * sin + x2 * cos], axis=-1)

    return jnp.concatenate([rot(x[..., :half], row), rot(x[..., half:], col)], axis=-1).astype(x.dtype)


def dense_block_attention(q, k, v):
    b, hq, s, hd = q.shape
    hkv = k.shape[1]
    g = hq // hkv
    nqb = s // B_QBLOCK
    qb = q.reshape(b, hkv, g, nqb, B_QBLOCK, hd).transpose(3, 0, 1, 2, 4, 5)

    def one_block(qblk):
        sc = jnp.einsum('bhgqd,bhkd->bhgqk', qblk, k).astype(jnp.float32) / math.sqrt(hd)
        p = jax.nn.softmax(sc, axis=-1)
        return jnp.einsum('bhgqk,bhkd->bhgqd', p.astype(v.dtype), v)

    o = lax.map(one_block, qb)
    return o.transpose(1, 2, 3, 0, 4, 5).reshape(b, hq, s, hd)


def mixer_ab(h, w_in, a_qn, a_kn, b_qn, b_kn, w_out, rel_bias):
    b, s, _ = h.shape
    proj = jnp.einsum('bsd,de->bse', h, w_in)
    cuts = [A_W, 2 * A_W, 3 * A_W, 3 * A_W + B_QW, 3 * A_W + B_QW + B_KVW]
    aq, ak, av, bq, bk, bv = jnp.split(proj, cuts, axis=-1)
    oa = dilated_attention(rms_norm(split_heads(aq, A_HEADS), a_qn),
                           rms_norm(split_heads(ak, A_HEADS), a_kn),
                           split_heads(av, A_HEADS), rel_bias)
    ob = dense_block_attention(axial_rope(rms_norm(split_heads(bq, B_HEADS), b_qn)),
                               axial_rope(rms_norm(split_heads(bk, B_KV_HEADS), b_kn)),
                               split_heads(bv, B_KV_HEADS))
    o = jnp.concatenate([oa, ob], axis=1).transpose(0, 2, 1, 3).reshape(b, s, L0_OUT)
    return jnp.einsum('bse,ed->bsd', o, w_out)


def mixer_c(h, w_in, c_qn, c_kn, sink, w_out, rel_bias):
    b, s, _ = h.shape
    proj = jnp.einsum('bsd,de->bse', h, w_in)
    cq, ck, cv = jnp.split(proj, [C_QW, C_QW + C_KVW], axis=-1)
    bias = rel_bias[:, t5_bucket(local_offsets(C_BLOCK))]
    o, _, _ = band_attention(rms_norm(split_heads(cq, C_HEADS), c_qn),
                             rms_norm(split_heads(ck, C_KV_HEADS), c_kn),
                             split_heads(cv, C_KV_HEADS), C_RADIUS, C_BLOCK, bias, sink)
    o = o.transpose(0, 2, 1, 3).reshape(b, s, C_QW)
    return jnp.einsum('bse,ed->bsd', o, w_out)


def ec_moe(h, w_router, w_gate, w_up, w_down):
    b, s, d = h.shape
    cap = CAPACITY_FACTOR * s // N_EXPERTS
    aff = jax.nn.softmax(jnp.einsum('bsd,de->bse', h, w_router).astype(jnp.float32), axis=-1)
    gates, idx = lax.top_k(jnp.swapaxes(aff, 1, 2), cap)
    xs = jax.vmap(lambda hb, ib: hb[ib])(h, idx)
    act = jax.nn.silu(jnp.einsum('becd,edf->becf', xs, w_gate)) * jnp.einsum('becd,edf->becf', xs, w_up)
    y = jnp.einsum('becf,efd->becd', act, w_down) * gates[..., None].astype(h.dtype)

    def combine(ib, yb):
        return jnp.zeros((s, d), yb.dtype).at[ib.reshape(-1)].add(yb.reshape(-1, d))

    return jax.vmap(combine)(idx, y)


def setup_inputs(seed: int = 0) -> dict:
    key = jax.random.key(seed)
    ks = jax.random.split(key, 25)

    def nrm(k, shape, scale):
        return jax.random.normal(k, shape, jnp.float32) * scale

    def gain(k, n):
        return 1.0 + 0.02 * jax.random.normal(k, (n,), jnp.float32)

    return {
        'x': nrm(ks[0], (BATCH, SEQ, D_MODEL), 1.0),
        'rel_bias': nrm(ks[1], (BIAS_HEADS, NUM_BUCKETS), 0.5),
        'l0_norm_attn': gain(ks[2], D_MODEL),
        'l0_w_in': nrm(ks[3], (D_MODEL, L0_IN), D_MODEL ** -0.5),
        'l0_a_qnorm': gain(ks[4], HEAD_DIM),
        'l0_a_knorm': gain(ks[5], HEAD_DIM),
        'l0_b_qnorm': gain(ks[6], HEAD_DIM),
        'l0_b_knorm': gain(ks[7], HEAD_DIM),
        'l0_w_out': nrm(ks[8], (L0_OUT, D_MODEL), L0_OUT ** -0.5),
        'l0_norm_ffn': gain(ks[9], D_MODEL),
        'l0_router': nrm(ks[10], (D_MODEL, N_EXPERTS), D_MODEL ** -0.5),
        'l0_w_gate': nrm(ks[11], (N_EXPERTS, D_MODEL, D_EXPERT), D_MODEL ** -0.5),
        'l0_w_up': nrm(ks[12], (N_EXPERTS, D_MODEL, D_EXPERT), D_MODEL ** -0.5),
        'l0_w_down': nrm(ks[13], (N_EXPERTS, D_EXPERT, D_MODEL), D_EXPERT ** -0.5),
        'l1_norm_attn': gain(ks[14], D_MODEL),
        'l1_w_in': nrm(ks[15], (D_MODEL, L1_IN), D_MODEL ** -0.5),
        'l1_c_qnorm': gain(ks[16], HEAD_DIM),
        'l1_c_knorm': gain(ks[17], HEAD_DIM),
        'l1_sink': nrm(ks[18], (C_HEADS,), 1.0),
        'l1_w_out': nrm(ks[19], (C_QW, D_MODEL), C_QW ** -0.5),
        'l1_norm_ffn': gain(ks[20], D_MODEL),
        'l1_router': nrm(ks[21], (D_MODEL, N_EXPERTS), D_MODEL ** -0.5),
        'l1_w_gate': nrm(ks[22], (N_EXPERTS, D_MODEL, D_EXPERT), D_MODEL ** -0.5),
        'l1_w_up': nrm(ks[23], (N_EXPERTS, D_MODEL, D_EXPERT), D_MODEL ** -0.5),
        'l1_w_down': nrm(ks[24], (N_EXPERTS, D_EXPERT, D_MODEL), D_EXPERT ** -0.5),
    }


def reference(x, rel_bias,
              l0_norm_attn, l0_w_in, l0_a_qnorm, l0_a_knorm, l0_b_qnorm, l0_b_knorm, l0_w_out,
              l0_norm_ffn, l0_router, l0_w_gate, l0_w_up, l0_w_down,
              l1_norm_attn, l1_w_in, l1_c_qnorm, l1_c_knorm, l1_sink, l1_w_out,
              l1_norm_ffn, l1_router, l1_w_gate, l1_w_up, l1_w_down):
    attn_norms = [l0_norm_attn, l1_norm_attn]
    mixers = [
        lambda h: mixer_ab(h, l0_w_in, l0_a_qnorm, l0_a_knorm, l0_b_qnorm, l0_b_knorm, l0_w_out, rel_bias),
        lambda h: mixer_c(h, l1_w_in, l1_c_qnorm, l1_c_knorm, l1_sink, l1_w_out, rel_bias),
    ]
    ffns = [
        (l0_norm_ffn, l0_router, l0_w_gate, l0_w_up, l0_w_down),
        (l1_norm_ffn, l1_router, l1_w_gate, l1_w_up, l1_w_down),
    ]
    for i in range(DEPTH):
        x = x + mixers[i](rms_norm(x, attn_norms[i]))
        g, wr, wg, wu, wd = ffns[i]
        x = x + ec_moe(rms_norm(x, g), wr, wg, wu, wd)
    return x
```

```cpp
#include <hip/hip_runtime.h>
#include <hip/hip_bf16.h>
#include <cstdio>
#include <cstdint>
#include <cmath>
#define MK_SINGLE 1
namespace pg8 {
#define PG8_LAS __attribute__((address_space(3)))
typedef unsigned short bf16_t;
typedef short bf16x8 __attribute__((ext_vector_type(8)));
typedef float f32x4 __attribute__((ext_vector_type(4)));
typedef unsigned u32x4 __attribute__((ext_vector_type(4)));
constexpr int BM = 256, BK = 64, HALF = 128, HTB = HALF * BK * 2  , STAGE_BYTES = 8 * HTB, NXCD = 8, WGM = 8;

__host__ __device__ __forceinline__ int lds_byte(int r, int c) { const int st = (r >> 4) * 2 + (c >> 5), rr = r & 15, cc = c & 31, ob = rr * 64 + cc * 2; return st * 1024 + (ob ^ (((ob >> 9) & 1) << 5)); }
__host__ __device__ __forceinline__ void stage_rc(int b, int& R, int& C) { const int st = b / 1024, sb = b % 1024, swz = sb ^ (((sb >> 9) & 1) << 5); R = (st >> 1) * 16 + swz / 64; C = (st & 1) * 32 + (swz % 64) / 2; }
__host__ __device__ __forceinline__ int perm32(int rho) { const int n = rho >> 4, i = rho & 15; return 8 * (i >> 2) + 4 * n + (i & 3); }

struct Unit { int pm, pn, pb; };
struct Gemm { const bf16_t* A; const bf16_t* Bt; int M, N, K; };

struct StaticOrder {
    static constexpr bool GATHER = false;
    int nM, nN, nwg, G, c;
    __host__ __device__ void init(int M, int N, int G_, int c_) { nM = M / BM; nN = N / BM; nwg = nM * nN; G = G_; c = c_; }
    __host__ __device__ bool next(int i, Unit& u) const {
        const long L = (long)i * G + c; if (L >= nwg) return false;
        int wgid = (int)L; { const int q = nwg / NXCD, r = nwg % NXCD, xcd = wgid % NXCD, off = wgid / NXCD; wgid = (xcd < r ? xcd * (q + 1) : r * (q + 1) + (xcd - r) * q) + off; }
        const int nig = WGM * nN, gid = wgid / nig, fm = gid * WGM, gsz = (nM - fm) < WGM ? (nM - fm) : WGM;
        u.pm = fm + ((wgid % nig) % gsz); u.pn = (wgid % nig) / gsz; u.pb = u.pn; return true;
    }
    __device__ __forceinline__ void a_ready(const Unit&) const {}
    __device__ __forceinline__ void done(const Unit&) const {}
};

__device__ __forceinline__ unsigned cvt_pk_bf16(float lo, float hi) { unsigned r; asm volatile("v_cvt_pk_bf16_f32 %0, %1, %2" : "=v"(r) : "v"(lo), "v"(hi)); return r; }
typedef float f32x2 __attribute__((ext_vector_type(2)));
template <int ACT  > struct EpiBf16 {
    static constexpr bool PERM = true, AFTER_DRAIN = false, HEADPERM = false; static_assert(ACT == 0, "EpiBf16: ACT is 0 here");
    bf16_t* O; int ldc; const float* bias; int split_cols; size_t split_stride; float scale0;
    __device__ __forceinline__ void operator()(const f32x4 (&acc)[2][2][4][2], const Unit& u, int wr, int wc, int fr, int fq) const {
        const int row0 = u.pm * BM + wr * 64 + fr; int colt = u.pn * BM; bf16_t* base = O;
        float sc = 1.f; if (split_cols) { const int t = colt / split_cols; base += (size_t)t * split_stride; colt -= t * split_cols; if (t == 0) sc = scale0; }
        const int col0 = colt + wc * 32 + 8 * fq, bcol0 = u.pn * BM + wc * 32 + 8 * fq;
        f32x4 bv[2][2];
#pragma unroll
        for (int bj = 0; bj < 2; ++bj)
#pragma unroll
            for (int n = 0; n < 2; ++n) bv[bj][n] = bias ? *(const f32x4*)(bias + bcol0 + bj * HALF + 4 * n) : (f32x4){0.f, 0.f, 0.f, 0.f};
#pragma unroll
        for (int ai = 0; ai < 2; ++ai)
#pragma unroll
            for (int m = 0; m < 4; ++m) { bf16_t* rowp = base + (size_t)(row0 + ai * HALF + m * 16) * ldc + col0;
#pragma unroll
                for (int bj = 0; bj < 2; ++bj) { f32x4 v0 = acc[ai][bj][m][0] + bv[bj][0], v1 = acc[ai][bj][m][1] + bv[bj][1];
                    v0 = v0 * sc; v1 = v1 * sc; u32x4 w; w.x = cvt_pk_bf16(v0[0], v0[1]); w.y = cvt_pk_bf16(v0[2], v0[3]); w.z = cvt_pk_bf16(v1[0], v1[1]); w.w = cvt_pk_bf16(v1[2], v1[3]);
                    *(u32x4*)(rowp + bj * HALF) = w; } }
    }
};
template <unsigned ASC = 0x7f7f7f7fu> __device__ __forceinline__ f32x4 mfma8(bf16x8 w0, bf16x8 w1, bf16x8 x0, bf16x8 x1, f32x4 c) {
    typedef int v4i_ __attribute__((ext_vector_type(4))); typedef int v8i_ __attribute__((ext_vector_type(8)));
    const v4i_ a0 = __builtin_bit_cast(v4i_, w0), a1 = __builtin_bit_cast(v4i_, w1), b0 = __builtin_bit_cast(v4i_, x0), b1 = __builtin_bit_cast(v4i_, x1);
    const v8i_ A = __builtin_shufflevector(a0, a1, 0, 1, 2, 3, 4, 5, 6, 7), B = __builtin_shufflevector(b0, b1, 0, 1, 2, 3, 4, 5, 6, 7);
    asm volatile("v_mfma_scale_f32_16x16x128_f8f6f4 %0, %1, %2, %0, %3, %4 op_sel_hi:[0,0,0]" : "+v"(c) : "v"(A), "v"(B), "v"(0x79797979), "v"(ASC));
    return c;
}
template <class Epi, class Sched, bool ALIGN_EPI = false, bool SP2 = false, bool F8 = false, unsigned ASC = 0x7f7f7f7fu>
__device__ __forceinline__ void gemm_phase(PG8_LAS unsigned char* lds, const Gemm g, const Sched& S, const Epi& E) {
    const int tid = threadIdx.x, wid = __builtin_amdgcn_readfirstlane(tid >> 6), lane = tid & 63, wr = wid >> 2, wc = wid & 3, fr = lane & 15, fq = lane >> 4;
    const int K = g.K, nt = K / BK;
    unsigned voffA[2], voffB[2];
#pragma unroll
    for (int i = 0; i < 2; ++i) { int R, C; stage_rc(tid * 16 + i * 8192, R, C); const int Rb = Epi::HEADPERM ? (64 * (R >> 5) + perm32(R & 31)) : (Epi::PERM ? ((R & ~31) + perm32(R & 31)) : R);
        voffA[i] = (unsigned)(R * K + C) * 2u; voffB[i] = (unsigned)(Rb * K + C) * 2u; }
    const size_t kstep = (size_t)(BK * 2);
    const size_t hstep = (size_t)HALF * K * 2;
    const size_t tstep = 2 * hstep;
    const size_t hstepB = Epi::HEADPERM ? (size_t)32 * K * 2 : hstep;
    const unsigned ldsw = (unsigned)wid * 1024u;
    const int aoff = lds_byte(wr * 64 + fr, fq * 8), boff = lds_byte(wc * 32 + fr, fq * 8);
#define PG8_SA(b, h) (((b) * 2 + (h)) * HTB)
#define PG8_SB(b, h) ((4 + (b) * 2 + (h)) * HTB)
#define PG8_STAGE(bufoff, gbase, voff) do { _Pragma("unroll") for (int _i = 0; _i < 2; ++_i) \
        __builtin_amdgcn_global_load_lds((const unsigned*)((const char*)(gbase) + (voff)[_i]), (PG8_LAS unsigned*)(lds + (bufoff) + ldsw + _i * 8192), 16, 0, 0); } while (0)
#define PG8_STAGE_A(bufoff, gbase, h, nx) do { if constexpr (Sched::GATHER) { const unsigned vv_[2] = {(nx) ? vAn[h][0] : vA[h][0], (nx) ? vAn[h][1] : vA[h][1]}; PG8_STAGE(bufoff, gbase, vv_); } \
        else { PG8_STAGE(bufoff, (gbase) + (h) * hstep, voffA); } } while (0)
#define PG8_LDA(dst, b, h) do { _Pragma("unroll") for (int m = 0; m < 4; ++m) _Pragma("unroll") for (int k = 0; k < 2; ++k) dst[m][k] = *(const PG8_LAS bf16x8*)(lds + PG8_SA(b, h) + aoff + m * 2048 + k * 1024); } while (0)
#define PG8_LDB(dst, b, h) do { _Pragma("unroll") for (int n = 0; n < 2; ++n) _Pragma("unroll") for (int k = 0; k < 2; ++k) dst[n][k] = *(const PG8_LAS bf16x8*)(lds + PG8_SB(b, h) + boff + n * 2048 + k * 1024); } while (0)
#define PG8_MMA(ai, bj, At, Bt) do { __builtin_amdgcn_s_setprio(1); if constexpr (F8) { asm volatile("s_nop 3"); _Pragma("unroll") for (int m = 0; m < 4; ++m) _Pragma("unroll") for (int n = 0; n < 2; ++n) \
        acc[ai][bj][m][n] = mfma8<ASC>(Bt[n][0], Bt[n][1], At[m][0], At[m][1], acc[ai][bj][m][n]); } else { _Pragma("unroll") for (int m = 0; m < 4; ++m) _Pragma("unroll") for (int n = 0; n < 2; ++n) _Pragma("unroll") for (int k = 0; k < 2; ++k) \
        acc[ai][bj][m][n] = __builtin_amdgcn_mfma_f32_16x16x32_bf16(Bt[n][k], At[m][k], acc[ai][bj][m][n], 0, 0, 0); } __builtin_amdgcn_s_setprio(0); } while (0)
#define PG8_WAIT_V(n) asm volatile("s_waitcnt vmcnt(" #n ")" ::: "memory")
#define PG8_WAIT_L(n) asm volatile("s_waitcnt lgkmcnt(" #n ")" ::: "memory")
#define PG8_BAR __builtin_amdgcn_s_barrier()
#define PG8_SCHED __builtin_amdgcn_sched_barrier(0)
    Unit cur, nxt; int ui = 0;
    if (!S.next(0, cur)) return;
    f32x4 acc[2][2][4][2];
#pragma unroll
    for (int a = 0; a < 2; ++a)
#pragma unroll
        for (int b = 0; b < 2; ++b)
#pragma unroll
            for (int m = 0; m < 4; ++m)
#pragma unroll
                for (int n = 0; n < 2; ++n) acc[a][b][m][n] = (f32x4){0.f, 0.f, 0.f, 0.f};
    bf16x8 At[4][2], B0[2][2], B1[2][2];
    const char* cA = Sched::GATHER ? (const char*)g.A : (const char*)g.A + (size_t)cur.pm * tstep; const char* cB = (const char*)g.Bt + (size_t)cur.pb * tstep;
    unsigned vA[2][2] = {{0u, 0u}, {0u, 0u}}, vAn[2][2] = {{0u, 0u}, {0u, 0u}};
    static_assert(SP2 || !Sched::GATHER, "GATHER is wired into the SP2 loop only");
#define PG8_AOFF(dst, ui_) do { if constexpr (Sched::GATHER) { _Pragma("unroll") for (int h_ = 0; h_ < 2; ++h_) _Pragma("unroll") for (int i_ = 0; i_ < 2; ++i_) { int R_, C_; stage_rc(tid * 16 + i_ * 8192, R_, C_); \
        dst[h_][i_] = S.a_off(ui_, h_ * HALF + R_) + (unsigned)C_ * 2u; } } } while (0)
    PG8_AOFF(vA, 0);
    S.a_ready(cur);
    if constexpr (SP2) {
        PG8_STAGE(PG8_SB(0, 0), cB, voffB); PG8_STAGE(PG8_SB(0, 1), cB + hstepB, voffB); PG8_STAGE_A(PG8_SA(0, 0), cA, 0, false); PG8_STAGE_A(PG8_SA(0, 1), cA, 1, false);
        if (wr == 1) PG8_BAR;
        PG8_WAIT_V(2); PG8_BAR;
        PG8_STAGE(PG8_SB(1, 0), cB + kstep, voffB); PG8_STAGE_A(PG8_SA(1, 0), cA + kstep, 0, false); PG8_STAGE(PG8_SB(1, 1), cB + hstepB + kstep, voffB);
        PG8_WAIT_V(6); PG8_BAR;
    } else {
        PG8_STAGE(PG8_SB(0, 0), cB, voffB); PG8_STAGE(PG8_SA(0, 0), cA, voffA); PG8_STAGE(PG8_SB(0, 1), cB + hstepB, voffB); PG8_STAGE(PG8_SA(0, 1), cA + hstep, voffA);
        if (wr == 1) PG8_BAR;
        PG8_WAIT_V(4); PG8_BAR;
        PG8_STAGE(PG8_SB(1, 0), cB + kstep, voffB); PG8_STAGE(PG8_SA(1, 0), cA + kstep, voffA); PG8_STAGE(PG8_SB(1, 1), cB + hstepB + kstep, voffB);
        PG8_WAIT_V(6); PG8_BAR;
    }
    for (;;) {
        const bool has_next = S.next(ui + 1, nxt);
        const char* nA = Sched::GATHER ? cA : (has_next ? (const char*)g.A + (size_t)nxt.pm * tstep : cA);
        if constexpr (Sched::GATHER) { if (has_next) { PG8_AOFF(vAn, ui + 1); } else { _Pragma("unroll") for (int h_ = 0; h_ < 2; ++h_) _Pragma("unroll") for (int i_ = 0; i_ < 2; ++i_) vAn[h_][i_] = vA[h_][i_]; } } const char* nB = has_next ? (const char*)g.Bt + (size_t)nxt.pb * tstep : cB;
#pragma nounroll
        for (int t = 0; t < nt; t += 2) {
            const bool last = (t == nt - 2);
            const char* a1 = cA + (size_t)(t + 1) * kstep;
            const char* a2 = last ? nA : cA + (size_t)(t + 2) * kstep; const char* b2 = last ? nB : cB + (size_t)(t + 2) * kstep;
            const char* a3 = a2 + kstep; const char* b3 = b2 + kstep;
            if (last && has_next) S.a_ready(nxt);
            if constexpr (SP2) {
            PG8_LDB(B0, 0, 0); PG8_LDB(B1, 0, 1); PG8_SCHED; PG8_LDA(At, 0, 0); PG8_STAGE_A(PG8_SA(1, 1), a1, 1, false);
            PG8_WAIT_V(8); PG8_WAIT_L(0); PG8_BAR; PG8_MMA(0, 0, At, B0); PG8_MMA(0, 1, At, B1); PG8_BAR; PG8_SCHED;
            PG8_LDA(At, 0, 1); PG8_STAGE(PG8_SB(0, 0), b2, voffB); PG8_STAGE(PG8_SB(0, 1), b2 + hstepB, voffB); PG8_STAGE_A(PG8_SA(0, 0), a2, 0, last);
            PG8_WAIT_V(8); PG8_WAIT_L(0); PG8_BAR; PG8_MMA(1, 0, At, B0); PG8_MMA(1, 1, At, B1); PG8_BAR; PG8_SCHED;
            PG8_LDB(B0, 1, 0); PG8_LDB(B1, 1, 1); PG8_SCHED; PG8_LDA(At, 1, 0); PG8_STAGE_A(PG8_SA(0, 1), a2, 1, last);
            PG8_WAIT_V(8); PG8_WAIT_L(0); PG8_BAR; PG8_MMA(0, 0, At, B0); PG8_MMA(0, 1, At, B1); PG8_BAR; PG8_SCHED;
            PG8_LDA(At, 1, 1); PG8_STAGE(PG8_SB(1, 0), b3, voffB); PG8_STAGE(PG8_SB(1, 1), b3 + hstepB, voffB); PG8_STAGE_A(PG8_SA(1, 0), a3, 0, last);
            PG8_WAIT_V(8); PG8_WAIT_L(0); PG8_BAR; PG8_MMA(1, 0, At, B0); PG8_MMA(1, 1, At, B1); PG8_BAR; PG8_SCHED;
            } else {
            PG8_LDB(B0, 0, 0); PG8_SCHED; PG8_LDA(At, 0, 0); PG8_STAGE(PG8_SA(1, 1), a1 + hstep, voffA);
            PG8_WAIT_L(8); PG8_BAR; PG8_WAIT_L(0); PG8_MMA(0, 0, At, B0); PG8_BAR; PG8_SCHED;
            PG8_LDB(B1, 0, 1); PG8_STAGE(PG8_SB(0, 0), b2, voffB);
            PG8_BAR; PG8_WAIT_L(0); PG8_MMA(0, 1, At, B1); PG8_BAR;
            PG8_LDA(At, 0, 1); PG8_STAGE(PG8_SA(0, 0), a2, voffA);
            PG8_BAR; PG8_WAIT_L(0); PG8_MMA(1, 0, At, B0); PG8_BAR; PG8_SCHED;
            PG8_STAGE(PG8_SB(0, 1), b2 + hstepB, voffB);
            PG8_WAIT_V(6); PG8_BAR; PG8_MMA(1, 1, At, B1); PG8_BAR;
            PG8_LDB(B0, 1, 0); PG8_SCHED; PG8_LDA(At, 1, 0); PG8_STAGE(PG8_SA(0, 1), a2 + hstep, voffA);
            PG8_WAIT_L(8); PG8_BAR; PG8_WAIT_L(0); PG8_MMA(0, 0, At, B0); PG8_BAR; PG8_SCHED;
            PG8_LDB(B1, 1, 1); PG8_STAGE(PG8_SB(1, 0), b3, voffB);
            PG8_BAR; PG8_WAIT_L(0); PG8_MMA(0, 1, At, B1); PG8_BAR;
            PG8_LDA(At, 1, 1); PG8_STAGE(PG8_SA(1, 0), a3, voffA);
            PG8_BAR; PG8_WAIT_L(0); PG8_MMA(1, 0, At, B0); PG8_BAR; PG8_SCHED;
            PG8_STAGE(PG8_SB(1, 1), b3 + hstepB, voffB);
            PG8_WAIT_V(6); PG8_BAR; PG8_MMA(1, 1, At, B1); PG8_BAR;
            }
        }
        if constexpr (F8) asm volatile("s_nop 15\n\ts_nop 15\n\ts_nop 15" ::: "memory");
        if constexpr (ALIGN_EPI) { if (wr == 0) PG8_BAR; }
        if constexpr (!Epi::AFTER_DRAIN) { E(acc, cur, wr, wc, fr, fq); S.done(cur); }
        if (!has_next) break;
#pragma unroll
        for (int a = 0; a < 2; ++a)
#pragma unroll
            for (int b = 0; b < 2; ++b)
#pragma unroll
                for (int m = 0; m < 4; ++m)
#pragma unroll
                    for (int n = 0; n < 2; ++n) acc[a][b][m][n] = (f32x4){0.f, 0.f, 0.f, 0.f};
        cur = nxt; cA = nA; cB = nB; ++ui;
        if constexpr (Sched::GATHER) { _Pragma("unroll") for (int h_ = 0; h_ < 2; ++h_) _Pragma("unroll") for (int i_ = 0; i_ < 2; ++i_) vA[h_][i_] = vAn[h_][i_]; }
        if constexpr (ALIGN_EPI) { if (wr == 1) PG8_BAR; }
    }
    PG8_WAIT_V(0);
    if constexpr (!ALIGN_EPI) { if (wr == 0) PG8_BAR; }
    PG8_BAR;
    if constexpr (Epi::AFTER_DRAIN) { E.fused(acc, cur, wr, wc, fr, fq, lds, wid, lane); S.done(cur); }
#undef PG8_SA
#undef PG8_SB
#undef PG8_STAGE
#undef PG8_LDA
#undef PG8_STAGE_A
#undef PG8_AOFF
#undef PG8_LDB
#undef PG8_MMA
#undef PG8_WAIT_V
#undef PG8_WAIT_L
#undef PG8_BAR
#undef PG8_SCHED
}
}

namespace attn_body {
using bf16=__hip_bfloat16;
using bf16x8=__attribute__((ext_vector_type(8)))short;
using s16x4=__attribute__((ext_vector_type(4)))short;
using f32x16=__attribute__((ext_vector_type(16)))float;
using f32x4=__attribute__((ext_vector_type(4)))float;
using u32x4=__attribute__((ext_vector_type(4)))unsigned;
constexpr int SEQ=8192,D=64;
constexpr int NW=8,QBLK=32,QB=QBLK*NW,KVBLK=64,NQB=SEQ/QB;
constexpr int QP8=512,KP8=128,VTP=SEQ,OP=1024, ATTN_UNIT_ROWS=QB; constexpr float OSCALE=32.f;
__host__ __device__ __forceinline__ int vt_pos(int k){ const int half=k>>5,k5=k&31; return 32*((k5>>2)&1)+16*half+(k5&3)+4*(k5>>3); }
typedef int v8i_t __attribute__((ext_vector_type(8))); typedef int v4i_t __attribute__((ext_vector_type(4)));
__device__ __forceinline__ f32x16 qk8(bf16x8 klo,bf16x8 khi,v8i_t q,f32x16 c){ const v4i_t a0=__builtin_bit_cast(v4i_t,klo),a1=__builtin_bit_cast(v4i_t,khi);
  const v8i_t A=__builtin_shufflevector(a0,a1,0,1,2,3,4,5,6,7); return __builtin_amdgcn_mfma_scale_f32_32x32x64_f8f6f4(A,q,c,0,0,0,0x7f7f7f7f,0,0x75757575); }
__device__ __forceinline__ f32x16 pv8(v8i_t p,bf16x8 vlo,bf16x8 vhi,f32x16 c){ const v4i_t b0=__builtin_bit_cast(v4i_t,vlo),b1=__builtin_bit_cast(v4i_t,vhi);
  const v8i_t B=__builtin_shufflevector(b0,b1,0,1,2,3,4,5,6,7); return __builtin_amdgcn_mfma_scale_f32_32x32x64_f8f6f4(p,B,c,1,0,0,0x7f7f7f7f,0,0x7f7f7f7f); }
__device__ __forceinline__ unsigned pk4f8(float a,float b,float c,float d){ unsigned w=0u; w=__builtin_amdgcn_cvt_pk_fp8_f32(a,b,w,false); w=__builtin_amdgcn_cvt_pk_fp8_f32(c,d,w,true); return w; }
__device__ __forceinline__ unsigned pk4u8(float a,float b,float c,float d){ unsigned w=__builtin_amdgcn_cvt_pk_u8_f32(a,0u,0u); w=__builtin_amdgcn_cvt_pk_u8_f32(b,1u,w); w=__builtin_amdgcn_cvt_pk_u8_f32(c,2u,w); return __builtin_amdgcn_cvt_pk_u8_f32(d,3u,w); }
__device__ __forceinline__ int crow(int r,int hi){return (r&3)+8*(r>>2)+4*hi;}
#define SBAR() __builtin_amdgcn_sched_barrier(0)
constexpr int NSLOT=4, SLOTB=4096;
constexpr int LDS_K=0, LDS_V=NSLOT*SLOTB, LDS_WS=2*NSLOT*SLOTB, LDS_OST=LDS_WS+NW*64*4, LDS_FLAG=LDS_OST+NW*4096, LDS_BYTES=LDS_FLAG+64;
constexpr float C2=0.125f*1.4426950408889634f;
__device__ __forceinline__ void glds16(const void*gsrc,unsigned lds_dst){unsigned keep;
  asm volatile("s_mov_b32 %0, m0\n\ts_mov_b32 m0, %2\n\ts_nop 0\n\tglobal_load_lds_dwordx4 %1, off\n\ts_mov_b32 m0, %0":"=&s"(keep):"v"(gsrc),"s"(lds_dst):"memory");}
__device__ __forceinline__ void glds16h(const void*gsrc,unsigned lds_dst){unsigned keep;
  asm volatile("s_mov_b32 %0, m0\n\ts_mov_b32 m0, %2\n\ts_mov_b32 exec_hi, 0\n\tglobal_load_lds_dwordx4 %1, off\n\ts_mov_b32 exec_hi, -1\n\ts_mov_b32 m0, %0":"=&s"(keep):"v"(gsrc),"s"(lds_dst):"memory");}
__device__ __forceinline__ void glds16hs(const void*sbase,unsigned voff,unsigned lds_dst){unsigned keep;
  asm volatile("s_mov_b32 %0, m0\n\ts_mov_b32 m0, %3\n\ts_mov_b32 exec_hi, 0\n\tglobal_load_lds_dwordx4 %1, %2\n\ts_mov_b32 exec_hi, -1\n\ts_mov_b32 m0, %0":"=&s"(keep):"v"(voff),"s"(sbase),"s"(lds_dst):"memory");}
__device__ __forceinline__ float max3f(float a,float b,float c){float r;asm("v_max3_f32 %0, %1, %2, %3":"=v"(r):"v"(a),"v"(b),"v"(c));return r;}
__device__ __forceinline__ float max2f(float a,float b){float r;asm("v_max_f32_e32 %0, %1, %2":"=v"(r):"v"(a),"v"(b));return r;}
__device__ __forceinline__ float fadd_s(float a,float b){float r;asm("v_add_f32_e32 %0, %1, %2":"=v"(r):"v"(a),"v"(b));return r;}
__device__ __forceinline__ float fsub_s(float a,float b){float r;asm("v_sub_f32_e32 %0, %1, %2":"=v"(r):"v"(a),"v"(b));return r;}
typedef float f32x2_t __attribute__((ext_vector_type(2))); typedef __bf16 bf16x2_t __attribute__((ext_vector_type(2)));
__device__ __forceinline__ unsigned cvtpk_s(float lo,float hi){f32x2_t v={lo,hi};bf16x2_t b=__builtin_convertvector(v,bf16x2_t);return __builtin_bit_cast(unsigned,b);}
#define WAIT_BAR(N) asm volatile("s_waitcnt vmcnt(" #N ") lgkmcnt(0)\n\ts_barrier":::"memory")

__device__ __forceinline__ void qkt(f32x16&p0,f32x16&p1,const char*Kslot,v8i_t q8,const f32x16&negm,int r32,int hi){
  const char*kb=Kslot+hi*2048+r32*16;
  const bf16x8 a0=*reinterpret_cast<const bf16x8*>(kb),a1=*reinterpret_cast<const bf16x8*>(kb+1024),b0=*reinterpret_cast<const bf16x8*>(kb+512),b1=*reinterpret_cast<const bf16x8*>(kb+1536);
  p0=qk8(a0,a1,q8,negm); p1=qk8(b0,b1,q8,negm);
}
typedef __attribute__((address_space(3))) const char* lds_cptr;
typedef short v4i16_t __attribute__((ext_vector_type(4)));
__device__ __forceinline__ void kload1(bf16x8*kf,lds_cptr kp,int j){ kf[j]=*(const __attribute__((address_space(3))) bf16x8*)(kp+(j>>1)*512+(j&1)*1024); }
__device__ __forceinline__ void kload4(bf16x8*kf,lds_cptr kp){ kload1(kf,kp,0); kload1(kf,kp,1); kload1(kf,kp,2); kload1(kf,kp,3); }
__device__ __forceinline__ s16x4 vtr(lds_cptr p){ return __builtin_bit_cast(s16x4,__builtin_amdgcn_ds_read_tr16_b64_v4i16((__attribute__((address_space(3))) v4i16_t*)p)); }
__device__ __forceinline__ float rowmax(const f32x16&p0,const f32x16&p1){
  float a=max3f(p0[0],p0[1],p1[0]),b=max3f(p0[2],p0[3],p1[1]);a=max3f(a,p1[2],p1[3]);
  #pragma unroll
  for(int r=4;r<16;r+=4){a=max3f(a,p0[r],p0[r+1]);b=max3f(b,p0[r+2],p0[r+3]);a=max3f(a,p1[r],p1[r+1]);b=max3f(b,p1[r+2],p1[r+3]);}
  const float m=max2f(a,b);
  auto rr=__builtin_amdgcn_permlane32_swap(__float_as_uint(m),__float_as_uint(m),false,false);
  return max2f(__uint_as_float(rr[0]),__uint_as_float(rr[1]));
}
#ifndef ATTN_STORE16
#define ATTN_STORE16(p,v) (*(u32x4*)(p)=(v))
#endif
template<int THRL> __device__ __forceinline__ void attn_unit(int b,int qb,const unsigned char*Q,const unsigned char*__restrict__ K,const unsigned char*__restrict__ VT,unsigned char*O,char*shm){
  const int tid=threadIdx.x,lane=tid&63,r32=lane&31,hi=lane>>5; const int wid=__builtin_amdgcn_readfirstlane(tid>>6);
  const long rowbase=(long)b*SEQ; const int q0=qb*QB;
  const unsigned char*Qw=Q+(rowbase+q0+wid*QBLK)*QP8;
  const unsigned char*Kh=K+rowbase*KP8;
  const unsigned lds0=(unsigned)(uintptr_t)shm;
  float*wsf=(float*)(shm+LDS_WS)+wid*64;
  const unsigned char*ksrc=Kh+(long)(32*(wid&1))*KP8+(wid>>1)*16; const unsigned klo=(unsigned)(lane&31)*KP8;
  const unsigned char*vsrc=VT+(long)(32*(wid&1))*VTP+(wid>>1)*16; const unsigned vlo=(unsigned)(lane&31)*VTP;
  const unsigned kdst=lds0+LDS_K+(wid>>1)*1024+(wid&1)*512, vdst=lds0+LDS_V+(wid>>1)*1024+(wid&1)*512;
  #define DMA_K(t,slot) glds16hs(ksrc+(long)(t)*KVBLK*KP8,klo,(unsigned)__builtin_amdgcn_readfirstlane(kdst+(slot)))
  #define DMA_V(t,slot) glds16hs(vsrc+(long)(t)*KVBLK,vlo,(unsigned)__builtin_amdgcn_readfirstlane(vdst+(slot)))
  const char*Kbase=shm+LDS_K; bf16x8 kf[4];
  const lds_cptr shm3=(lds_cptr)shm; const lds_cptr kp0=shm3+LDS_K+hi*2048+r32*16; const lds_cptr vp0=shm3+LDS_V+hi*2048+r32*16;
  constexpr int NT=SEQ/KVBLK;
  v8i_t q8; { const v4i_t qa=*reinterpret_cast<const v4i_t*>(Qw+(long)r32*QP8+32*hi), qb_=*reinterpret_cast<const v4i_t*>(Qw+(long)r32*QP8+32*hi+16); q8=__builtin_shufflevector(qa,qb_,0,1,2,3,4,5,6,7); }
  const int one4_=((lane&15)==((lane>>4)&1))?0x38383838:0; const v8i_t vones={one4_,one4_,one4_,one4_,one4_,one4_,one4_,one4_};
  constexpr float ZS=1.f/256.f, RBZ=32.5f*ZS;
  f32x16 o[2]; f32x4 o2; float refz=0.f;
  #define PKN(X,B) __builtin_bit_cast(unsigned,__builtin_amdgcn_cvt_pknorm_u16(X[B],X[(B)+1]))
  #define PRM(w1,w0) __builtin_amdgcn_perm((w1),(w0),0x07050301u)
  #define PACK16(PC,J,X,orv) do{ const unsigned w0_=PKN(X,0),w1_=PKN(X,2),w2_=PKN(X,4),w3_=PKN(X,6),w4_=PKN(X,8),w5_=PKN(X,10),w6_=PKN(X,12),w7_=PKN(X,14); \
      PC[(J)]=(int)PRM(w1_,w0_); PC[(J)+1]=(int)PRM(w3_,w2_); PC[(J)+2]=(int)PRM(w5_,w4_); PC[(J)+3]=(int)PRM(w7_,w6_); \
      asm("v_or3_b32 %0, %0, %1, %2":"+v"(orv):"v"(PC[(J)]),"v"(PC[(J)+1])); asm("v_or3_b32 %0, %0, %1, %2":"+v"(orv):"v"(PC[(J)+2]),"v"(PC[(J)+3])); }while(0)
  #define PIN(x) asm volatile("; pin " #x :"+v"(x))
  #define VRD(i) do{ vf[i]=*(const __attribute__((address_space(3))) bf16x8*)(vp_+((i)>>1)*512+((i)&1)*1024); }while(0)
  #define KRD(G,j) do{ if(G){ kload1(kf,kp0+sl_next,j); } }while(0)
  #define ROT() do{sl_prev=sl_cur;sl_cur=sl_next;sl_next=sl_nx2;sl_nx2=(sl_nx2==(NSLOT-1)*SLOTB)?0:sl_nx2+SLOTB;}while(0)
  #define STEP(PC,PP,t,GK,GV,GL) do{ SBAR(); \
    const lds_cptr vp_=vp0+sl_prev; \
    VRD(0); VRD(1); VRD(2); VRD(3); \
    C0=qk8(kf[0],kf[1],q8,negm); \
    C1=qk8(kf[2],kf[3],q8,negm); SBAR(); \
    if(GK){DMA_K((t)+4,sl_cur);} if(GV){DMA_V((t)+2,sl_nx2);} SBAR(); \
    o[0]=pv8(PP,vf[0],vf[1],o[0]); KRD(GL,0); KRD(GL,1); \
    PACK16(PC,0,C0,orv); PIN(PC); PIN(o[0]); SBAR(); \
    o[1]=pv8(PP,vf[2],vf[3],o[1]); KRD(GL,2); KRD(GL,3); \
    PACK16(PC,4,C1,orv); PIN(PC); PIN(o[1]); SBAR(); \
    o2=__builtin_amdgcn_mfma_scale_f32_16x16x128_f8f6f4(PP,vones,o2,1,0,0,0x7f7f7f7f,0,0x7f7f7f7f); PIN(o2); SBAR(); \
    }while(0)
  #define ENDW(tt) do{ if((tt)+4<NT){WAIT_BAR(4);} else if((tt)+3<NT){WAIT_BAR(3);} else if((tt)+2<NT){WAIT_BAR(2);} else {WAIT_BAR(0);} }while(0)
  unsigned*vflag=(unsigned*)(shm+LDS_FLAG);
  #pragma nounroll
  for(int attempt=0;;++attempt){
    f32x16 negm=f32x16{};asm volatile("":"+v"(negm));
    f32x16 C0,C1; v8i_t p8A,p8B; bf16x8 vf[4]; unsigned orv=0u;
    o[0]=f32x16{};o[1]=f32x16{};o2=f32x4{};
    int sl_prev=0,sl_cur=0,sl_next=SLOTB,sl_nx2=2*SLOTB;
    DMA_K(0,0);DMA_V(0,0);DMA_K(1,SLOTB);DMA_V(1,SLOTB);DMA_K(2,2*SLOTB);DMA_K(3,3*SLOTB);
    WAIT_BAR(5);
    qkt(C0,C1,Kbase,q8,negm,r32,hi);asm volatile("s_nop 15\n\ts_nop 15\n\ts_nop 7":"+v"(C0),"+v"(C1));
    { const float rm=(attempt==0)?rowmax(C0,C1):refz; const float cy=RBZ-rm;
      _Pragma("unroll") for(int r=0;r<16;++r){C0[r]=fadd_s(C0[r],cy);C1[r]=fadd_s(C1[r],cy);}
      _Pragma("unroll") for(int r=0;r<16;++r)negm[r]=cy; asm volatile("":"+v"(negm));
      PACK16(p8A,0,C0,orv); PACK16(p8A,4,C1,orv); }
    WAIT_BAR(3);
    DMA_K(4,0);DMA_V(2,2*SLOTB);
    ROT();
    kload4(kf,kp0+sl_cur);
    WAIT_BAR(3);
    int t=1;
    for(;t+5<NT;t+=2){
      STEP(p8B,p8A,t,true,true,true);     WAIT_BAR(4); ROT();
      STEP(p8A,p8B,t+1,true,true,true);   WAIT_BAR(4); ROT();
    }
    for(;t+1<NT;t+=2){
      STEP(p8B,p8A,t,(t+4<NT),(t+2<NT),(t+1<NT));       ENDW(t);   ROT();
      STEP(p8A,p8B,t+1,(t+5<NT),(t+3<NT),(t+2<NT));     ENDW(t+1); ROT();
    }
    STEP(p8B,p8A,NT-1,false,false,false);
    { const lds_cptr vp_=vp0+sl_cur; VRD(0); VRD(1); VRD(2); VRD(3); SBAR();
      o[0]=pv8(p8B,vf[0],vf[1],o[0]); o[1]=pv8(p8B,vf[2],vf[3],o[1]); o2=__builtin_amdgcn_mfma_scale_f32_16x16x128_f8f6f4(p8B,vones,o2,1,0,0,0x7f7f7f7f,0,0x7f7f7f7f); }
    bool bad=__any((orv&0xC0C0C0C0u)!=0u);
#if defined(PROBE_VAR) && PROBE_VAR==9
    bad=true;
#endif
    if(lane==0)vflag[wid]=(bad&&attempt==0)?1u:0u;
    asm volatile("s_waitcnt lgkmcnt(0)\n\ts_barrier":::"memory");
    const bool redo=__any(vflag[lane&7]!=0u);
    if(__builtin_expect(!redo,1))break;
    { f32x16 z0=f32x16{}; asm volatile("":"+v"(z0)); float rmx=-3.0e38f;
      for(int tt=0;tt<NT;++tt){
        asm volatile("s_barrier":::"memory");
        DMA_K(tt,0); WAIT_BAR(0);
        f32x16 m0,m1; qkt(m0,m1,Kbase,q8,z0,r32,hi); asm volatile("s_nop 15\n\ts_nop 15\n\ts_nop 7":"+v"(m0),"+v"(m1));
        rmx=max2f(rmx,rowmax(m0,m1)); }
      refz=rmx;
      asm volatile("s_waitcnt lgkmcnt(0)\n\ts_barrier":::"memory"); }
  }
  #undef PKN
  #undef PRM
  #undef PACK16
  #undef PIN
  #undef VRD
  #undef KRD
  #undef STEP
  #undef ENDW
  #undef ROT
  if((lane&15)<2){
    #pragma unroll
    for(int i=0;i<4;++i)wsf[32+16*(lane&15)+4*(lane>>4)+i]=o2[i]; }
  asm volatile("s_waitcnt lgkmcnt(0)":::"memory");
  float rli[16];
  #pragma unroll
  for(int r=0;r<16;++r)rli[r]=__builtin_amdgcn_rcpf(wsf[32+crow(r,hi)]);
  unsigned char*Ow=O+(rowbase+q0+wid*QBLK)*OP;
  { unsigned char*stg=(unsigned char*)(shm+LDS_OST)+wid*2048;
    #pragma unroll
    for(int r=0;r<16;++r){const int orow=crow(r,hi); const float s_=rli[r]*OSCALE;
      const unsigned w=(unsigned)__builtin_amdgcn_cvt_pk_fp8_f32(o[0][r]*s_,o[1][r]*s_,0,false);
      stg[orow*64+r32]=(unsigned char)(w&0xffu); stg[orow*64+32+r32]=(unsigned char)((w>>8)&0xffu);}
    asm volatile("s_waitcnt lgkmcnt(0)":::"memory");
    #pragma unroll
    for(int i=0;i<2;++i){const int row=i*16+(lane>>2),ch=lane&3; const u32x4 v=*(const u32x4*)(stg+row*64+ch*16); ATTN_STORE16(Ow+(long)row*OP+ch*16,v);} }
  asm volatile("s_waitcnt lgkmcnt(0)\n\ts_barrier":::"memory");
  #undef DMA_K
  #undef DMA_V
}
constexpr int ATTN_LDS_BYTES=LDS_BYTES;
struct AttnTensors { const unsigned char* Q; const unsigned char* K; const unsigned char* VT; unsigned char* O; };
template<int THRL=8> __device__ __forceinline__ void attn_phase(char*lds,const AttnTensors&T,int grid,int block){
  const int nx=(grid%8==0)?8:1, x=block%nx, slot=block/nx, per=grid/nx;
  for(int s8=x;s8<8;s8+=nx){ const int b=s8>>1,kvh=s8&1;
    for(int u=slot;u<128;u+=per){ const int h=4*kvh+(u>>5),qb=u&31;
      attn_unit<THRL>(b,qb,T.Q+h*D,T.K+kvh*D,T.VT+(long)(b*2+kvh)*D*SEQ,T.O+h*D,lds); } }
}
#undef SBAR
#undef WAIT_BAR
}


namespace pg8 {
template <bool RESID_F32> struct EpiResid {
    static constexpr bool PERM = true, AFTER_DRAIN = false, HEADPERM = false;
    const void* resid; bf16_t* out; int ldc;
    __device__ __forceinline__ void operator()(const f32x4 (&acc)[2][2][4][2], const Unit& u, int wr, int wc, int fr, int fq) const {
        const int row0 = u.pm * BM + wr * 64 + fr, col0 = u.pn * BM + wc * 32 + 8 * fq;
#pragma unroll
        for (int ai = 0; ai < 2; ++ai)
#pragma unroll
            for (int m = 0; m < 4; ++m) { const size_t ro = (size_t)(row0 + ai * HALF + m * 16) * ldc + col0;
#pragma unroll
                for (int bj = 0; bj < 2; ++bj) { const size_t off = ro + bj * HALF; f32x4 r0, r1;
                    if constexpr (RESID_F32) { r0 = *(const f32x4*)((const float*)resid + off); r1 = *(const f32x4*)((const float*)resid + off + 4); }
                    else { const u32x4 w = *(const u32x4*)((const bf16_t*)resid + off);
                        r0 = (f32x4){__uint_as_float(w.x << 16), __uint_as_float(w.x & 0xffff0000u), __uint_as_float(w.y << 16), __uint_as_float(w.y & 0xffff0000u)};
                        r1 = (f32x4){__uint_as_float(w.z << 16), __uint_as_float(w.z & 0xffff0000u), __uint_as_float(w.w << 16), __uint_as_float(w.w & 0xffff0000u)}; }
                    const f32x4 v0 = r0 + acc[ai][bj][m][0], v1 = r1 + acc[ai][bj][m][1];
                    u32x4 o; o.x = cvt_pk_bf16(v0[0], v0[1]); o.y = cvt_pk_bf16(v0[2], v0[3]); o.z = cvt_pk_bf16(v1[0], v1[1]); o.w = cvt_pk_bf16(v1[2], v1[3]);
                    *(u32x4*)(out + off) = o; } }
    }
};
__device__ __forceinline__ float silu_mul(float g, float u) { const float e = __builtin_amdgcn_exp2f(-g); return (g * u) * __builtin_amdgcn_rcpf(1.0f + e); }
__device__ __forceinline__ unsigned pk4_fp8(float a, float b, float c, float d) { unsigned w = 0u; w = __builtin_amdgcn_cvt_pk_fp8_f32(a, b, w, false); w = __builtin_amdgcn_cvt_pk_fp8_f32(c, d, w, true); return w; }
__device__ __forceinline__ float clamp448(float v) { return __builtin_amdgcn_fmed3f(v, -448.f, 448.f); }
struct EpiSwiGLU {
    static constexpr bool PERM = true, AFTER_DRAIN = false, HEADPERM = false;
    unsigned char* O; int ldc;
    __device__ __forceinline__ void operator()(const f32x4 (&acc)[2][2][4][2], const Unit& u, int wr, int wc, int fr, int fq) const {
        const int row0 = u.pm * BM + wr * 64 + fr, col0 = u.pn * HALF + wc * 32 + 8 * fq;
#pragma unroll
        for (int ai = 0; ai < 2; ++ai)
#pragma unroll
            for (int m = 0; m < 4; ++m) { unsigned char* rowp = O + (size_t)(row0 + ai * HALF + m * 16) * ldc + col0;
                const f32x4 g0 = acc[ai][0][m][0], g1 = acc[ai][0][m][1], u0 = acc[ai][1][m][0], u1 = acc[ai][1][m][1];
                f32x2 w_; unsigned lo = pk4_fp8(clamp448(silu_mul(g0[0], u0[0])), clamp448(silu_mul(g0[1], u0[1])), clamp448(silu_mul(g0[2], u0[2])), clamp448(silu_mul(g0[3], u0[3])));
                unsigned hi = pk4_fp8(clamp448(silu_mul(g1[0], u1[0])), clamp448(silu_mul(g1[1], u1[1])), clamp448(silu_mul(g1[2], u1[2])), clamp448(silu_mul(g1[3], u1[3])));
                typedef unsigned u32x2_ __attribute__((ext_vector_type(2))); (void)w_; *(u32x2_*)rowp = (u32x2_){lo, hi}; }
    }
};
constexpr float YSCALE = 32.0f;
struct EpiDown {
    static constexpr bool PERM = true, AFTER_DRAIN = false, HEADPERM = false;
    unsigned char* O; const float* gate; int ldc;
    __device__ __forceinline__ void operator()(const f32x4 (&acc)[2][2][4][2], const Unit& u, int wr, int wc, int fr, int fq) const {
        const int row0 = u.pm * BM + wr * 64 + fr, col0 = u.pn * BM + wc * 32 + 8 * fq;
#pragma unroll
        for (int ai = 0; ai < 2; ++ai)
#pragma unroll
            for (int m = 0; m < 4; ++m) { const int row = row0 + ai * HALF + m * 16; const float gt = gate[row] * YSCALE; unsigned char* rowp = O + (size_t)row * ldc + col0;
#pragma unroll
                for (int bj = 0; bj < 2; ++bj) { const f32x4 v0 = acc[ai][bj][m][0] * gt, v1 = acc[ai][bj][m][1] * gt;
                    typedef unsigned u32x2_ __attribute__((ext_vector_type(2))); u32x2_ w; w.x = pk4_fp8(clamp448(v0[0]), clamp448(v0[1]), clamp448(v0[2]), clamp448(v0[3])); w.y = pk4_fp8(clamp448(v1[0]), clamp448(v1[1]), clamp448(v1[2]), clamp448(v1[3]));
                    *(u32x2_*)(rowp + bj * HALF) = w; } }
    }
};
typedef float f32x2e __attribute__((ext_vector_type(2)));
__device__ __forceinline__ unsigned pk4_fp8(float a, float b, float c, float d);
template <bool F8OUT = false> __device__ __forceinline__ void head_tile_store(const f32x4 (&acc)[2][2][4][2], bf16_t* obase  , int opitch, const float* gain, float scale, const f32x2e* rope, int row0, int fq) {
    asm volatile("" : "+v"(fq), "+v"(row0));
    f32x4 g[2][2];
    if (gain) {
#pragma unroll
        for (int bj = 0; bj < 2; ++bj)
#pragma unroll
            for (int n = 0; n < 2; ++n) g[bj][n] = *(const f32x4*)(gain + 32 * bj + 8 * fq + 4 * n);
    }
#pragma unroll
    for (int ai = 0; ai < 2; ++ai)
#pragma unroll
        for (int m = 0; m < 4; ++m) {
            const int row = row0 + ai * HALF + m * 16;
            f32x4 x[2][2];
#pragma unroll
            for (int bj = 0; bj < 2; ++bj)
#pragma unroll
                for (int n = 0; n < 2; ++n) x[bj][n] = acc[ai][bj][m][n];
            if (gain) {
                float ss = 0.f;
#pragma unroll
                for (int bj = 0; bj < 2; ++bj)
#pragma unroll
                    for (int n = 0; n < 2; ++n) ss += (x[bj][n][0] * x[bj][n][0] + x[bj][n][1] * x[bj][n][1]) + (x[bj][n][2] * x[bj][n][2] + x[bj][n][3] * x[bj][n][3]);
                ss += __shfl_xor(ss, 16); ss += __shfl_xor(ss, 32);
                const float r = scale / sqrtf(ss * (1.f / 64.f) + 1e-6f);
#pragma unroll
                for (int bj = 0; bj < 2; ++bj)
#pragma unroll
                    for (int n = 0; n < 2; ++n) x[bj][n] = x[bj][n] * r * g[bj][n];
            }
            if (rope) {
                const int t = row & 8191; const bool second = (fq & 2) != 0;
#pragma unroll
                for (int bj = 0; bj < 2; ++bj) { const int pos = bj ? (t & 63) : (t >> 6); const f32x2e* tb = rope + pos * 16 + 8 * (fq & 1);
#pragma unroll
                    for (int n = 0; n < 2; ++n)
#pragma unroll
                        for (int e = 0; e < 4; ++e) { const float p = __shfl_xor(x[bj][n][e], 32); const f32x2e cs = tb[4 * n + e]; const float v = x[bj][n][e];
                            x[bj][n][e] = second ? (p * cs.y + v * cs.x) : (v * cs.x - p * cs.y); } }
            }
            if constexpr (F8OUT) { unsigned char* rowp8 = (unsigned char*)obase + (size_t)row * opitch + 8 * fq; typedef unsigned u32x2_ __attribute__((ext_vector_type(2)));
#pragma unroll
                for (int bj = 0; bj < 2; ++bj) *(u32x2_*)(rowp8 + 32 * bj) = (u32x2_){pk4_fp8(x[bj][0][0], x[bj][0][1], x[bj][0][2], x[bj][0][3]), pk4_fp8(x[bj][1][0], x[bj][1][1], x[bj][1][2], x[bj][1][3])};
                continue; }
            bf16_t* rowp = obase + (size_t)row * opitch + 8 * fq;
#pragma unroll
            for (int bj = 0; bj < 2; ++bj) { u32x4 w; w.x = cvt_pk_bf16(x[bj][0][0], x[bj][0][1]); w.y = cvt_pk_bf16(x[bj][0][2], x[bj][0][3]); w.z = cvt_pk_bf16(x[bj][1][0], x[bj][1][1]); w.w = cvt_pk_bf16(x[bj][1][2], x[bj][1][3]);
                *(u32x4*)(rowp + 32 * bj) = w; }
        }
}
__host__ __device__ __forceinline__ int vt_pos(int k) { const int half = k >> 5, k5 = k & 31; return 32 * ((k5 >> 2) & 1) + 16 * half + (k5 & 3) + 4 * (k5 >> 3); }
__device__ __forceinline__ void vt_tile_store(const f32x4 (&acc)[2][2][4][2], unsigned char* VT, int kvh, int row0, int fq) {
    asm volatile("" : "+v"(fq), "+v"(row0));
#pragma unroll
    for (int ai = 0; ai < 2; ++ai)
#pragma unroll
        for (int m = 0; m < 4; ++m) {
            const int row = row0 + ai * HALF + m * 16, b = row >> 13, t = row & 8191;
            unsigned char* col = VT + ((size_t)(b * 2 + kvh) * 64) * 8192 + (t & ~63) + vt_pos(t & 63);
#pragma unroll
            for (int bj = 0; bj < 2; ++bj)
#pragma unroll
                for (int n = 0; n < 2; ++n) { const f32x4 x = acc[ai][bj][m][n]; const unsigned w = pk4_fp8(x[0], x[1], x[2], x[3]); const int d = 32 * bj + 8 * fq + 4 * n;
#pragma unroll
                    for (int e = 0; e < 4; ++e) col[(size_t)(d + e) * 8192] = (unsigned char)(w >> (8 * e)); }
        }
}
struct EpiHeads0 {
    static constexpr bool PERM = true, AFTER_DRAIN = false, HEADPERM = true;
    bf16_t *AQ, *AK, *AV, *BQ, *BK, *BV; const float *aqn, *akn, *bqn, *bkn; const f32x2e* rope; float qscale, aqscale;
    __device__ __forceinline__ void operator()(const f32x4 (&acc)[2][2][4][2], const Unit& u, int wr, int wc, int fr, int fq) const {
        const int row0 = u.pm * BM + wr * 64 + fr, pn = u.pn, hd = 4 * (pn & 1) + wc;
        if (pn < 2)      head_tile_store(acc, AQ + hd * 64, 512, aqn, aqscale, nullptr, row0, fq);
        else if (pn < 4) head_tile_store(acc, AK + hd * 64, 512, akn, 1.0f, nullptr, row0, fq);
        else if (pn < 6) head_tile_store(acc, AV + hd * 64, 512, nullptr, 1.0f, nullptr, row0, fq);
        else if (pn < 8) head_tile_store<true>(acc, (bf16_t*)((unsigned char*)BQ + hd * 64), 512, bqn, 16.f * qscale, rope, row0, fq);
        else if (wc < 2) head_tile_store<true>(acc, (bf16_t*)((unsigned char*)BK + wc * 64), 128, bkn, 1.0f, rope, row0, fq);
        else             vt_tile_store(acc, (unsigned char*)BV, wc - 2, row0, fq);
    }
};
struct EpiHeads1 {
    static constexpr bool PERM = true, AFTER_DRAIN = false, HEADPERM = true;
    bf16_t *CQ, *CK, *CV; const float *cqn, *ckn; float qscale;
    __device__ __forceinline__ void operator()(const f32x4 (&acc)[2][2][4][2], const Unit& u, int wr, int wc, int fr, int fq) const {
        const int row0 = u.pm * BM + wr * 64 + fr, pn = u.pn;
        if (pn < 4)       head_tile_store(acc, CQ + (4 * pn + wc) * 64, 1024, cqn, qscale, nullptr, row0, fq);
        else if (pn == 4) head_tile_store(acc, CK + wc * 64, 256, ckn, 1.0f, nullptr, row0, fq);
        else              head_tile_store(acc, CV + wc * 64, 256, nullptr, 1.0f, nullptr, row0, fq);
    }
};
struct MoeGateUpOrder {
    static constexpr bool GATHER = true;
    int G, c; const PG8_LAS unsigned* rowoff;
    __device__ __forceinline__ unsigned a_off(int ui, int r) const { return rowoff[ui * 256 + r]; }
    __device__ __forceinline__ bool next(int i, Unit& u) const {
        const long L = (long)i * G + c; if (L >= 4096) return false;
        const int e = (int)(L >> 8), t = (int)(L & 255), xcd = t & 7, slot = t >> 3;
        const int pml = 4 * (xcd & 3) + (slot & 3), pn = 8 * (xcd >> 2) + (slot >> 2);
        u.pm = 16 * e + pml; u.pn = pn; u.pb = 16 * e + pn; return true;
    }
    __device__ __forceinline__ void a_ready(const Unit&) const {}
    __device__ __forceinline__ void done(const Unit&) const {}
};
struct MoeDownOrder {
    static constexpr bool GATHER = false;
    int G, c;
    __device__ __forceinline__ bool next(int i, Unit& u) const {
        const long L = (long)i * G + c; if (L >= 1024) return false;
        const int rnd = (int)(L >> 8), t = (int)(L & 255), xcd = t & 7, slot = t >> 3;
        const int e = 4 * rnd + (xcd >> 1), pml = 8 * (xcd & 1) + (slot & 7), pn = slot >> 3;
        u.pm = 16 * e + pml; u.pn = pn; u.pb = 4 * e + pn; return true;
    }
    __device__ __forceinline__ void a_ready(const Unit&) const {}
    __device__ __forceinline__ void done(const Unit&) const {}
};
}

#ifndef PG8_SP2
#define PG8_SP2 true
#endif
#ifndef PG8_ALIGN
#define PG8_ALIGN true
#endif
#ifndef PROBE_MASK
#define PROBE_MASK 0
#endif
#ifndef MK_SINGLE
#define MK_SINGLE 0
#endif

constexpr int NWAVES = 8;
constexpr int NB = 4, SEQ = 8192, DM = 1024, NTOK = NB * SEQ;
constexpr int L0_IN = 2304, L1_IN = 1536, NE = 16, DFF = 2048, CAP = 1024, NPAIR = NB * NE * CAP;
constexpr float RMS_EPS = 1e-6f, LOG2E = 1.4426950408889634f, QSCALE = 0.125f * LOG2E, NEGBIG = -1e30f;
constexpr int N_PHASES = 21;
#ifndef G_P1
#define G_P1 144
#endif
constexpr int CVT1_P6 = 3072, CVT1_P16 = 3072, CVT1_LATE = CVT1_P6 + CVT1_P16;

constexpr size_t MiB = 1u << 20;
constexpr size_t WS_CTL = 0, CTL_ZERO_BYTES = 1 * MiB;
constexpr size_t WS_ROPE = 1 * MiB;
constexpr size_t WS_WIN0 = 2 * MiB, WS_WOUT0 = 7 * MiB, WS_WIN1 = 9 * MiB, WS_WOUT1 = 12 * MiB;
constexpr size_t WS_AFF = 14 * MiB;
constexpr size_t WS_SEL = 16 * MiB;
constexpr size_t WS_IDX = 18 * MiB, WS_GATE = 18 * MiB + 512 * 1024;
constexpr size_t WS_XN = 20 * MiB;
constexpr size_t WS_WGU0 = 84 * MiB, WS_WGU1 = 180 * MiB;
constexpr size_t WS_WDN0 = 148 * MiB, WS_WDN1 = 244 * MiB;
constexpr size_t WS_R = 276 * MiB;
constexpr size_t WS_AQ = WS_R, WS_AK = WS_AQ + 32 * MiB, WS_AV = WS_AK + 32 * MiB, WS_BQ = WS_AV + 32 * MiB, WS_BK = WS_BQ + 32 * MiB, WS_BV = WS_BK + 8 * MiB;
constexpr size_t WS_CQ = WS_R, WS_CK = WS_CQ + 64 * MiB, WS_CV = WS_CK + 16 * MiB;
constexpr size_t WS_O = WS_R + 248 * MiB;
constexpr size_t WS_ST = WS_R + 320 * MiB, WS_ML = WS_R + 384 * MiB;
constexpr size_t WS_XS = WS_R, WS_ACT = WS_R + 64 * MiB, WS_Y = WS_R + 192 * MiB, WS_XN8 = WS_R + 320 * MiB;
constexpr size_t WS_XR = WS_R + 512 * MiB;
constexpr size_t WS_END = WS_XR + 64 * MiB;
static_assert(WS_BV + 8 * MiB <= WS_O && WS_CV + 16 * MiB <= WS_O && WS_O + 64 * MiB <= WS_END, "d_ws map");
constexpr int CW_TMO = 0, CW_BAR = 4096;

constexpr int SCR_BYTES = 147456, LDSCTL_OFF = SCR_BYTES, MISC_OFF = LDSCTL_OFF + 320, LDS_BYTES = SCR_BYTES + 512;

#define GAS __attribute__((address_space(1)))
#define LAS __attribute__((address_space(3)))
typedef unsigned short bf16;
typedef unsigned v4u __attribute__((ext_vector_type(4)));
typedef unsigned v2u __attribute__((ext_vector_type(2)));
typedef int v4i __attribute__((ext_vector_type(4)));
typedef float f32x4 __attribute__((ext_vector_type(4)));
typedef float f32x2 __attribute__((ext_vector_type(2)));
typedef float f32x16 __attribute__((ext_vector_type(16)));
typedef short bf16x8 __attribute__((ext_vector_type(8)));
typedef short s16x4 __attribute__((ext_vector_type(4)));
typedef GAS unsigned gu32;
#define RLX_AGENT __ATOMIC_RELAXED, __HIP_MEMORY_SCOPE_AGENT
#define LDS_WAIT() asm volatile("s_waitcnt lgkmcnt(0)" ::: "memory")
#define VM_WAIT() asm volatile("s_waitcnt vmcnt(0)" ::: "memory")
__device__ __forceinline__ unsigned pkbf(float lo, float hi) { unsigned r; asm volatile("v_cvt_pk_bf16_f32 %0, %1, %2" : "=v"(r) : "v"(lo), "v"(hi)); return r; }
__device__ __forceinline__ float bf_lo(unsigned w) { return __uint_as_float(w << 16); }
__device__ __forceinline__ float bf_hi(unsigned w) { return __uint_as_float(w & 0xffff0000u); }
__device__ __forceinline__ float wave_sum(float v) {
#pragma unroll
    for (int o = 1; o < 64; o <<= 1) v += __shfl_xor(v, o);
    return v;
}

#define XB_TMO      128
#define XB_XCNT(j)  (256  + 64 * (j))
#define XB_XSUB(j)  (1280 + 64 * (j))
#define XB_XGEN(j)  (2304 + 64 * (j))
#define XB_TOP      3328
#define XB_TOPGEN   3392
#define XCD_BAR_WORDS 3456
#define XB_SPIN_CAP (1u << 18)
__device__ __forceinline__ unsigned xb_ld(unsigned* p)              { return __hip_atomic_load(p, __ATOMIC_RELAXED, __HIP_MEMORY_SCOPE_AGENT); }
__device__ __forceinline__ unsigned xb_add(unsigned* p, unsigned v) { return __hip_atomic_fetch_add(p, v, __ATOMIC_RELAXED, __HIP_MEMORY_SCOPE_AGENT); }
__device__ __forceinline__ unsigned xb_xcc_id() { return (unsigned)__builtin_amdgcn_s_getreg((3 << 11) | 20) & 0xFu; }
#define XB_SPIN(cond, bar) do { unsigned _sp = 0; while (cond) { __builtin_amdgcn_s_sleep(1); \
    if ((++_sp & 255u) == 0u) { if (xb_ld(&(bar)[XB_TMO])) break; if (_sp > XB_SPIN_CAP) { atomicAdd(&(bar)[XB_TMO], 1u); break; } } } } while (0)
struct XcdBarrier { unsigned* bar; unsigned x; volatile LAS unsigned* st; };
__device__ __forceinline__ XcdBarrier xcd_barrier_post(unsigned* bar, volatile LAS unsigned* st) {
    XcdBarrier b; b.bar = bar; b.x = xb_xcc_id(); b.st = st;
    if (threadIdx.x == 0) (void)xb_add(&bar[XB_XCNT(b.x)], 1u);
    return b;
}
__device__ __forceinline__ void xcd_barrier_complete(unsigned* bar, unsigned x, unsigned& nloc, unsigned& nx) {
    const unsigned G = gridDim.x * gridDim.y * gridDim.z;
    unsigned sum, cnt, mine, sp = 0u;
    for (;;) {
        sum = 0u; cnt = 0u; mine = 0u;
#pragma unroll
        for (unsigned j = 0; j < 16; ++j) { const unsigned c = xb_ld(&bar[XB_XCNT(j)]); sum += c; cnt += (c > 0u) ? 1u : 0u; mine = (j == x) ? c : mine; }
        if (sum == G) break;
        __builtin_amdgcn_s_sleep(1);
        if ((++sp & 255u) == 0u) { if (xb_ld(&bar[XB_TMO])) break; if (sp > XB_SPIN_CAP) { atomicAdd(&bar[XB_TMO], 1u); break; } }
    }
    nloc = mine > 0u ? mine : 1u; nx = cnt > 0u ? cnt : 1u;
}
__device__ __forceinline__ void xcd_barrier(const XcdBarrier& b) {
    asm volatile("s_waitcnt vmcnt(0)" ::: "memory");
    __syncthreads();
    if (threadIdx.x == 0) {
        unsigned* bar = b.bar;
        __builtin_amdgcn_s_waitcnt(0);
        unsigned nloc = b.st[0], nx = b.st[1];
        if (nloc == 0u) { xcd_barrier_complete(bar, b.x, nloc, nx); b.st[0] = nloc; b.st[1] = nx; }
        const unsigned old = xb_add(&bar[XB_XSUB(b.x)], 1u);
        const unsigned gen = old / nloc;
        if (old + 1u == (gen + 1u) * nloc) {
            __builtin_amdgcn_fence(__ATOMIC_RELEASE, "agent");
            asm volatile("s_waitcnt vmcnt(0)" ::: "memory");
            const unsigned og = xb_add(&bar[XB_TOP], 1u);
            const unsigned tg = og / nx;
            if (og + 1u == (tg + 1u) * nx) xb_add(&bar[XB_TOPGEN], 1u);
            else XB_SPIN(xb_ld(&bar[XB_TOPGEN]) == tg, bar);
            __builtin_amdgcn_fence(__ATOMIC_ACQUIRE, "agent");
            xb_add(&bar[XB_XGEN(b.x)], 1u);
            asm volatile("s_waitcnt vmcnt(0)" ::: "memory");
        } else {
            XB_SPIN(xb_ld(&bar[XB_XGEN(b.x)]) == gen, bar);
            __builtin_amdgcn_fence(__ATOMIC_ACQUIRE, "agent");
            asm volatile("s_waitcnt vmcnt(0)" ::: "memory");
        }
    }
    __syncthreads();
}

__device__ __forceinline__ void cvt_item(const float* __restrict__ src, int K, int N, bf16* dst, int kb, int nb, int drow0, LAS float* scr, int lane) {
    const int k0 = kb * 64, n0 = nb * 64;
    const float* s = src + (size_t)(k0 + (lane >> 4)) * N + n0 + 4 * (lane & 15);
    f32x4 v[16];
#pragma unroll
    for (int i = 0; i < 16; ++i) v[i] = *(const f32x4*)(s + (size_t)(4 * i) * N);
#pragma unroll
    for (int i = 0; i < 16; ++i) { LAS float* p = scr + (4 * i + (lane >> 4)) * 65 + 4 * (lane & 15); p[0] = v[i].x; p[1] = v[i].y; p[2] = v[i].z; p[3] = v[i].w; }
    LDS_WAIT();
    const int c = lane & 7;
#pragma unroll
    for (int j = 0; j < 8; ++j) { const int n = (lane >> 3) + 8 * j; const LAS float* q = scr + (8 * c) * 65 + n;
        v4u o; o.x = pkbf(q[0], q[65]); o.y = pkbf(q[130], q[195]); o.z = pkbf(q[260], q[325]); o.w = pkbf(q[390], q[455]);
        *(v4u*)(dst + (size_t)(drow0 + n) * K + k0 + 8 * c) = o; }
    LDS_WAIT();
}
__device__ __forceinline__ void cvt_item8(const float* __restrict__ src, int K, int N, unsigned char* dst, int kb, int nb, int drow0, float wscale, LAS float* scr, int lane) {
    const int k0 = kb * 64, n0 = nb * 64;
    const float* s = src + (size_t)(k0 + (lane >> 4)) * N + n0 + 4 * (lane & 15);
    f32x4 v[16];
#pragma unroll
    for (int i = 0; i < 16; ++i) v[i] = *(const f32x4*)(s + (size_t)(4 * i) * N);
#pragma unroll
    for (int i = 0; i < 16; ++i) { LAS float* p = scr + (4 * i + (lane >> 4)) * 65 + 4 * (lane & 15); p[0] = v[i].x * wscale; p[1] = v[i].y * wscale; p[2] = v[i].z * wscale; p[3] = v[i].w * wscale; }
    LDS_WAIT();
    const int c = lane & 3;
#pragma unroll
    for (int j = 0; j < 4; ++j) { const int n = (lane >> 2) + 16 * j; const LAS float* q = scr + (16 * c) * 65 + n;
        v4u o; o.x = pg8::pk4_fp8(q[0], q[65], q[130], q[195]); o.y = pg8::pk4_fp8(q[260], q[325], q[390], q[455]);
        o.z = pg8::pk4_fp8(q[520], q[585], q[650], q[715]); o.w = pg8::pk4_fp8(q[780], q[845], q[910], q[975]);
        *(v4u*)(dst + (size_t)(drow0 + n) * K + k0 + 16 * c) = o; }
    LDS_WAIT();
}
__device__ __forceinline__ void cvt_moe(const float* wg, const float* wu, const float* wd, unsigned char* WGU, unsigned char* WDN, LAS float* scr, int gw, int NGW, int lane, int it0 = 0, int it1 = 3 * 8192) {
    for (int it = it0 + gw; it < it1; it += NGW) {
        const int which = it >> 13, r = it & 8191, e = r >> 9, q = r & 511;
        if (which < 2) { const int kb = q >> 5, nb = q & 31, n0 = nb * 64;
            cvt_item8((which ? wu : wg) + (size_t)e * DM * DFF, DM, DFF, WGU + (size_t)e * 4096 * DM, kb, nb, (n0 >> 7) * 256 + (n0 & 127) + which * 128, which ? 64.f / LOG2E : 64.f * LOG2E, scr, lane); }
        else { const int kb = q >> 4, nb = q & 15;
            cvt_item8(wd + (size_t)e * DFF * DM, DFF, DM, WDN + (size_t)e * DM * DFF, kb, nb, nb * 64, 64.f, scr, lane); }
    }
}
struct CvtItem { const float* src; unsigned char* dst; int N, K; float wscale; };
__device__ __forceinline__ CvtItem cvt_moe_item(int it, const float* wg, const float* wu, const float* wd, unsigned char* WGU, unsigned char* WDN, int lane) {
    const int which = it >> 13, r = it & 8191, e = r >> 9, q = r & 511; CvtItem c;
    if (which < 2) { const int kb = q >> 5, nb = q & 31, n0 = nb * 64;
        c.N = DFF; c.K = DM; c.wscale = which ? 64.f / LOG2E : 64.f * LOG2E; c.src = (which ? wu : wg) + (size_t)e * DM * DFF + (size_t)(kb * 64 + (lane >> 4)) * DFF + n0 + 4 * (lane & 15);
        c.dst = WGU + (size_t)e * 4096 * DM + (size_t)((n0 >> 7) * 256 + (n0 & 127) + which * 128) * DM + kb * 64; }
    else { const int kb = q >> 4, nb = q & 15;
        c.N = DM; c.K = DFF; c.wscale = 64.f; c.src = wd + (size_t)e * DFF * DM + (size_t)(kb * 64 + (lane >> 4)) * DM + nb * 64 + 4 * (lane & 15);
        c.dst = WDN + (size_t)e * DM * DFF + (size_t)(nb * 64) * DFF + kb * 64; }
    return c;
}
#define CVT_LOAD(v, c) do { _Pragma("unroll") for (int i_ = 0; i_ < 16; ++i_) v[i_] = *(const f32x4*)((c).src + (size_t)(4 * i_) * (c).N); } while (0)
__device__ __forceinline__ void cvt_finish8(const f32x4 (&v)[16], const CvtItem& c, LAS float* scr, int lane) {
#pragma unroll
    for (int i = 0; i < 16; ++i) { LAS float* p = scr + (4 * i + (lane >> 4)) * 65 + 4 * (lane & 15); p[0] = v[i].x * c.wscale; p[1] = v[i].y * c.wscale; p[2] = v[i].z * c.wscale; p[3] = v[i].w * c.wscale; }
    LDS_WAIT();
    const int cc = lane & 3;
#pragma unroll
    for (int j = 0; j < 4; ++j) { const int n = (lane >> 2) + 16 * j; const LAS float* q = scr + (16 * cc) * 65 + n;
        v4u o; o.x = pg8::pk4_fp8(q[0], q[65], q[130], q[195]); o.y = pg8::pk4_fp8(q[260], q[325], q[390], q[455]);
        o.z = pg8::pk4_fp8(q[520], q[585], q[650], q[715]); o.w = pg8::pk4_fp8(q[780], q[845], q[910], q[975]);
        *(v4u*)(c.dst + (size_t)n * c.K + 16 * cc) = o; }
    LDS_WAIT();
}
__device__ __forceinline__ void cvt_moe_pipe(const float* wg, const float* wu, const float* wd, unsigned char* WGU, unsigned char* WDN, LAS float* scr, int gw, int NGW, int lane, int it0, int it1) {
    f32x4 va[16], vb[16]; CvtItem ca, cb;
    int it = it0 + gw;
    if (it < it1) { ca = cvt_moe_item(it, wg, wu, wd, WGU, WDN, lane); CVT_LOAD(va, ca); }
    while (it < it1) {
        const int i1 = it + NGW;
        if (i1 < it1) { cb = cvt_moe_item(i1, wg, wu, wd, WGU, WDN, lane); CVT_LOAD(vb, cb); }
        cvt_finish8(va, ca, scr, lane);
        if (i1 >= it1) break;
        const int i2 = i1 + NGW;
        if (i2 < it1) { ca = cvt_moe_item(i2, wg, wu, wd, WGU, WDN, lane); CVT_LOAD(va, ca); }
        cvt_finish8(vb, cb, scr, lane);
        it = i2;
    }
}
__device__ __forceinline__ void cvt_dense8(const float* w, int K, int N, unsigned char* dst, LAS float* scr, int gw, int NGW, int lane) {
    const int nnb = N / 64, items = (K / 64) * nnb;
    for (int it = gw; it < items; it += NGW) cvt_item8(w, K, N, dst, it / nnb, it % nnb, (it % nnb) * 64, 64.f, scr, lane);
}
__device__ __forceinline__ void cvt_dense(const float* w, int K, int N, bf16* dst, LAS float* scr, int gw, int NGW, int lane) {
    const int nnb = N / 64, items = (K / 64) * nnb;
    for (int it = gw; it < items; it += NGW) cvt_item(w, K, N, dst, it / nnb, it % nnb, (it % nnb) * 64, scr, lane);
}
__device__ __forceinline__ void rms_row2_to_fp8(const float* xrow, const float* g, unsigned char* orow, int lane) {
    const f32x4* xr = (const f32x4*)xrow + lane; const f32x4* gr = (const f32x4*)g + lane;
    f32x4 v[2][4]; float s0 = 0.f, s1 = 0.f;
#pragma unroll
    for (int j = 0; j < 4; ++j) { v[0][j] = xr[64 * j]; v[1][j] = xr[256 + 64 * j]; }
#pragma unroll
    for (int j = 0; j < 4; ++j) { s0 += (v[0][j].x * v[0][j].x + v[0][j].y * v[0][j].y) + (v[0][j].z * v[0][j].z + v[0][j].w * v[0][j].w); s1 += (v[1][j].x * v[1][j].x + v[1][j].y * v[1][j].y) + (v[1][j].z * v[1][j].z + v[1][j].w * v[1][j].w); }
    const float r0 = 1.0f / sqrtf(wave_sum(s0) * (1.f / DM) + RMS_EPS), r1 = 1.0f / sqrtf(wave_sum(s1) * (1.f / DM) + RMS_EPS);
    unsigned* o4 = (unsigned*)orow + lane;
#pragma unroll
    for (int j = 0; j < 4; ++j) { const f32x4 gg = gr[64 * j];
        o4[64 * j] = pg8::pk4_fp8(v[0][j].x * r0 * gg.x, v[0][j].y * r0 * gg.y, v[0][j].z * r0 * gg.z, v[0][j].w * r0 * gg.w);
        o4[256 + 64 * j] = pg8::pk4_fp8(v[1][j].x * r1 * gg.x, v[1][j].y * r1 * gg.y, v[1][j].z * r1 * gg.z, v[1][j].w * r1 * gg.w); }
}
__device__ __forceinline__ void rope_table(f32x2* tab, int j) {
    double th = 1.0;
    for (int k = 0; k < j; ++k) th *= 0.5623413251903491;
    const double x2 = th * th; double c = 1.0, s = th, tc = 1.0, ts = th;
#pragma unroll
    for (int n = 1; n <= 12; ++n) { tc *= -x2 * (1.0 / (double)((2 * n - 1) * (2 * n))); ts *= -x2 * (1.0 / (double)((2 * n) * (2 * n + 1))); c += tc; s += ts; }
    double cr = 1.0, sr = 0.0;
    for (int p = 0; p < 128; ++p) { tab[p * 16 + j] = (f32x2){(float)cr, (float)sr}; const double nc = cr * c - sr * s, ns = sr * c + cr * s; cr = nc; sr = ns; }
}
__device__ __forceinline__ void head_norm8(float (&y)[8], const float* gain, int li, float scale) {
    float ss = 0.f;
#pragma unroll
    for (int i = 0; i < 8; ++i) ss += y[i] * y[i];
    ss += __shfl_xor(ss, 1); ss += __shfl_xor(ss, 2); ss += __shfl_xor(ss, 4);
    const float rstd = scale / sqrtf(ss * (1.f / 64.f) + RMS_EPS);
    const f32x4 g0 = *(const f32x4*)(gain + 8 * li), g1 = *(const f32x4*)(gain + 8 * li + 4);
    y[0] *= rstd * g0.x; y[1] *= rstd * g0.y; y[2] *= rstd * g0.z; y[3] *= rstd * g0.w; y[4] *= rstd * g1.x; y[5] *= rstd * g1.y; y[6] *= rstd * g1.z; y[7] *= rstd * g1.w;
}
__device__ __forceinline__ void unpack8(const v4u w, float (&y)[8]) { y[0] = bf_lo(w.x); y[1] = bf_hi(w.x); y[2] = bf_lo(w.y); y[3] = bf_hi(w.y); y[4] = bf_lo(w.z); y[5] = bf_hi(w.z); y[6] = bf_lo(w.w); y[7] = bf_hi(w.w); }
__device__ __forceinline__ v4u pack8(const float (&y)[8]) { v4u w; w.x = pkbf(y[0], y[1]); w.y = pkbf(y[2], y[3]); w.z = pkbf(y[4], y[5]); w.w = pkbf(y[6], y[7]); return w; }
__device__ __forceinline__ void rope8(float (&y)[8], const f32x2* rope, int li, int t) {
    float py[8];
#pragma unroll
    for (int i = 0; i < 8; ++i) py[i] = __shfl_xor(y[i], 2);
    const int pos = (li & 4) ? (t & 63) : (t >> 6);
    const f32x2* tb = rope + pos * 16 + 8 * (li & 1);
    const bool second = (li & 2) != 0;
#pragma unroll
    for (int i = 0; i < 8; ++i) { const f32x2 cs = tb[i]; y[i] = second ? (py[i] * cs.y + y[i] * cs.x) : (y[i] * cs.x - py[i] * cs.y); }
}
constexpr int WT_PITCH = 1028;
__device__ __forceinline__ void norm_router_phase(const bf16* x1, const float* g, const float* Wr, unsigned char* XN8, float* AFF, LAS float* WT, int gw, int NGW, int lane, int tid) {
    for (int idx = tid; idx < NE * DM; idx += NWAVES * 64) { const int e = idx & 15, d = idx >> 4; WT[e * WT_PITCH + ((d >> 3) & 3) * 256 + (d >> 5) * 8 + (d & 7)] = Wr[idx] * g[d]; }
    __syncthreads();
    float gg[16];
#pragma unroll
    for (int j = 0; j < 2; ++j) { const f32x4 a = *(const f32x4*)(g + 512 * j + 8 * lane), b = *(const f32x4*)(g + 512 * j + 8 * lane + 4);
        gg[8 * j] = a.x; gg[8 * j + 1] = a.y; gg[8 * j + 2] = a.z; gg[8 * j + 3] = a.w; gg[8 * j + 4] = b.x; gg[8 * j + 5] = b.y; gg[8 * j + 6] = b.z; gg[8 * j + 7] = b.w; }
    const int ti = lane & 15, kq = lane >> 4;
    const LAS float* wrow = WT + ti * WT_PITCH + kq * 256;
    for (int grp = gw; grp < NTOK / 16; grp += NGW) {
        const int row0 = 16 * grp;
        const bf16* xp = x1 + (size_t)(row0 + ti) * DM + 8 * kq;
        f32x4 acc0 = {0.f, 0.f, 0.f, 0.f}, acc1 = acc0; float ss = 0.f;
        v4u cur[8], nxt[8];
#pragma unroll
        for (int i = 0; i < 8; ++i) cur[i] = *(const v4u*)(xp + 32 * i);
#pragma unroll 1
        for (int blk8 = 0; blk8 < 4; ++blk8) {
            if (blk8 < 3) {
#pragma unroll
                for (int i = 0; i < 8; ++i) nxt[i] = *(const v4u*)(xp + 32 * (8 * blk8 + 8 + i)); }
#pragma unroll
            for (int i = 0; i < 8; ++i) {
                float f[8]; unpack8(cur[i], f);
                const f32x4 wa = *(const LAS f32x4*)(wrow + 8 * (8 * blk8 + i)), wb = *(const LAS f32x4*)(wrow + 8 * (8 * blk8 + i) + 4);
                ss += (f[0] * f[0] + f[1] * f[1]) + (f[2] * f[2] + f[3] * f[3]) + (f[4] * f[4] + f[5] * f[5]) + (f[6] * f[6] + f[7] * f[7]);
                acc0 = __builtin_amdgcn_mfma_f32_16x16x4f32(wa.x, f[0], acc0, 0, 0, 0); acc1 = __builtin_amdgcn_mfma_f32_16x16x4f32(wa.y, f[1], acc1, 0, 0, 0);
                acc0 = __builtin_amdgcn_mfma_f32_16x16x4f32(wa.z, f[2], acc0, 0, 0, 0); acc1 = __builtin_amdgcn_mfma_f32_16x16x4f32(wa.w, f[3], acc1, 0, 0, 0);
                acc0 = __builtin_amdgcn_mfma_f32_16x16x4f32(wb.x, f[4], acc0, 0, 0, 0); acc1 = __builtin_amdgcn_mfma_f32_16x16x4f32(wb.y, f[5], acc1, 0, 0, 0);
                acc0 = __builtin_amdgcn_mfma_f32_16x16x4f32(wb.z, f[6], acc0, 0, 0, 0); acc1 = __builtin_amdgcn_mfma_f32_16x16x4f32(wb.w, f[7], acc1, 0, 0, 0); }
            if (blk8 < 3) {
#pragma unroll
                for (int i = 0; i < 8; ++i) cur[i] = nxt[i]; }
        }
        ss += __shfl_xor(ss, 16); ss += __shfl_xor(ss, 32);
        const float rstd = 1.0f / sqrtf(ss * (1.f / DM) + RMS_EPS);
        float lg[4], mx;
#pragma unroll
        for (int r = 0; r < 4; ++r) lg[r] = (acc0[r] + acc1[r]) * rstd;
        mx = fmaxf(fmaxf(lg[0], lg[1]), fmaxf(lg[2], lg[3])); mx = fmaxf(mx, __shfl_xor(mx, 16)); mx = fmaxf(mx, __shfl_xor(mx, 32));
        float ex[4], sm = 0.f;
#pragma unroll
        for (int r = 0; r < 4; ++r) { ex[r] = __builtin_amdgcn_exp2f((lg[r] - mx) * LOG2E); sm += ex[r]; }
        sm += __shfl_xor(sm, 16); sm += __shfl_xor(sm, 32);
        { const int row = row0 + ti; const float inv = 1.0f / sm;
#pragma unroll
          for (int r = 0; r < 4; ++r) AFF[((size_t)(4 * kq + r) * NB + (row >> 13)) * SEQ + (row & (SEQ - 1))] = ex[r] * inv; }
        const unsigned rbits = __float_as_uint(rstd);
        v4u xa[16], xb[16];
#pragma unroll
        for (int i = 0; i < 16; ++i) { const bf16* xr = x1 + (size_t)(row0 + i) * DM + 8 * lane; xa[i] = *(const v4u*)xr; xb[i] = *(const v4u*)(xr + 512); }
#pragma unroll
        for (int i = 0; i < 16; ++i) {
            const float rs = __uint_as_float((unsigned)__builtin_amdgcn_readlane((int)rbits, i));
            float v[16]; { float t[8]; unpack8(xa[i], t);
#pragma unroll
                for (int j = 0; j < 8; ++j) v[j] = t[j] * (rs * gg[j]);
                unpack8(xb[i], t);
#pragma unroll
                for (int j = 0; j < 8; ++j) v[8 + j] = t[j] * (rs * gg[8 + j]); }
            unsigned char* o = XN8 + (size_t)(row0 + i) * DM + 8 * lane;
            *(v2u*)o = (v2u){pg8::pk4_fp8(v[0], v[1], v[2], v[3]), pg8::pk4_fp8(v[4], v[5], v[6], v[7])};
            *(v2u*)(o + 512) = (v2u){pg8::pk4_fp8(v[8], v[9], v[10], v[11]), pg8::pk4_fp8(v[12], v[13], v[14], v[15])};
        }
    }
}
__device__ __forceinline__ void topk_phase(const float* AFF, int* IDX, float* GATE, int* SEL, LAS unsigned* sc, int G, int blk, int tid, int lane, int wave) {
    for (int prob = blk; prob < NE * NB; prob += G) {
        const int e = prob >> 2, b = prob & 3;
        const v4u* a = (const v4u*)(AFF + (size_t)prob * SEQ) + 4 * tid;
        unsigned u[16];
#pragma unroll
        for (int j = 0; j < 4; ++j) { const v4u w = a[j]; u[4 * j] = w.x; u[4 * j + 1] = w.y; u[4 * j + 2] = w.z; u[4 * j + 3] = w.w; }
        unsigned prefix = 0u; int it = 0;
        for (int bit = 30; bit >= 0; bit -= 2, ++it) {
            const int lo = bit >= 1 ? bit - 1 : 0; const unsigned step = 1u << lo;
            const unsigned c1 = prefix + step, c2 = prefix + 2u * step, c3 = prefix + 3u * step;
            int n1 = 0, n2 = 0, n3 = 0;
#pragma unroll
            for (int i = 0; i < 16; ++i) { n1 += (int)__builtin_popcountll(__ballot(u[i] >= c1)); n2 += (int)__builtin_popcountll(__ballot(u[i] >= c2)); n3 += (int)__builtin_popcountll(__ballot(u[i] >= c3)); }
            if (lane == 0) { sc[(it & 1) * 32 + wave] = (unsigned)n1; sc[(it & 1) * 32 + 8 + wave] = (unsigned)n2; sc[(it & 1) * 32 + 16 + wave] = (unsigned)n3; }
            __syncthreads();
            unsigned t1 = 0u, t2 = 0u, t3 = 0u;
#pragma unroll
            for (int w = 0; w < 8; ++w) { t1 += sc[(it & 1) * 32 + w]; t2 += sc[(it & 1) * 32 + 8 + w]; t3 += sc[(it & 1) * 32 + 16 + w]; }
            if (bit >= 1) { if (t3 >= (unsigned)CAP) prefix = c3; else if (t2 >= (unsigned)CAP) prefix = c2; else if (t1 >= (unsigned)CAP) prefix = c1; }
            else { if (t1 >= (unsigned)CAP) prefix = c1; }
        }
        { int c = 0;
#pragma unroll
          for (int i = 0; i < 16; ++i) c += (int)__builtin_popcountll(__ballot(u[i] > prefix));
          if (lane == 0) sc[64 + wave] = (unsigned)c;
          __syncthreads();
          unsigned tot = 0u;
#pragma unroll
          for (int w = 0; w < 8; ++w) tot += sc[64 + w];
          __syncthreads();
          sc[80] = tot; }
        __syncthreads();
        const unsigned T = prefix; const int n_gt = (int)sc[80], need_eq = CAP - n_gt;
        int cg = 0, ce = 0;
#pragma unroll
        for (int i = 0; i < 16; ++i) { cg += (u[i] > T) ? 1 : 0; ce += (u[i] == T) ? 1 : 0; }
        const int pack = cg | (ce << 16); int x = pack;
#pragma unroll
        for (int o = 1; o < 64; o <<= 1) { const int y = __shfl_up(x, o); if (lane >= o) x += y; }
        if (lane == 63) sc[96 + wave] = (unsigned)x;
        __syncthreads();
        int base = 0;
        for (int w = 0; w < wave; ++w) base += (int)sc[96 + w];
        const int excl = base + x - pack; int g = excl & 0xffff, q = excl >> 16;
        int sl[16];
#pragma unroll
        for (int i = 0; i < 16; ++i) {
            int s = -1;
            if (u[i] > T) { s = g + (q < need_eq ? q : need_eq); ++g; }
            else if (u[i] == T) { if (q < need_eq) s = g + q; ++q; }
            sl[i] = s;
            if (s >= 0) { IDX[(size_t)prob * CAP + s] = 16 * tid + i; GATE[(size_t)prob * CAP + s] = __uint_as_float(u[i]); }
        }
        v4i* so = (v4i*)(SEL + ((size_t)b * NE + e) * SEQ) + 4 * tid;
#pragma unroll
        for (int j = 0; j < 4; ++j) so[j] = (v4i){sl[4 * j], sl[4 * j + 1], sl[4 * j + 2], sl[4 * j + 3]};
        __syncthreads();
    }
}
__device__ __forceinline__ void gather_phase(const unsigned char* XN8, const int* IDX, unsigned char* XS, int gw, int NGW, int lane) {
    for (int row = gw; row < NPAIR; row += NGW) {
        const int b = (row >> 10) & 3, tok = IDX[row];
        *((v4u*)(XS + (size_t)row * DM) + lane) = *((const v4u*)(XN8 + ((size_t)b * SEQ + tok) * DM) + lane);
    }
}
__device__ __forceinline__ void unpack8_fp8(const v2u w, float (&y)[8]) {
    const auto a = __builtin_amdgcn_cvt_pk_f32_fp8((int)w.x, false), b = __builtin_amdgcn_cvt_pk_f32_fp8((int)w.x, true), c = __builtin_amdgcn_cvt_pk_f32_fp8((int)w.y, false), d = __builtin_amdgcn_cvt_pk_f32_fp8((int)w.y, true);
    y[0] = a[0]; y[1] = a[1]; y[2] = b[0]; y[3] = b[1]; y[4] = c[0]; y[5] = c[1]; y[6] = d[0]; y[7] = d[1]; }
__device__ __forceinline__ void combine_phase(bf16* x, const unsigned char* Y  , const int* SEL, const float* g, bf16* XN, float* fout, int gw, int NGW, int lane) {
    constexpr int R = 4;
    for (int row0 = R * gw; row0 < NTOK; row0 += R * NGW) {
        const int b = row0 >> 13, s0 = row0 & (SEQ - 1);
        bf16* xr = x + (size_t)row0 * DM + 8 * lane;
        v4u w0[R], w1[R]; int sel[R];
        const int* selp = SEL + ((size_t)b * NE + (lane & 15)) * SEQ + s0;
#pragma unroll
        for (int r = 0; r < R; ++r) { w0[r] = *(const v4u*)(xr + (size_t)r * DM); w1[r] = *(const v4u*)(xr + (size_t)r * DM + 512); sel[r] = selp[r]; }
        float a[R][16]; unsigned mk[R];
#pragma unroll
        for (int r = 0; r < R; ++r) { float t[8]; unpack8(w0[r], t);
#pragma unroll
            for (int i = 0; i < 8; ++i) a[r][i] = t[i];
            unpack8(w1[r], t);
#pragma unroll
            for (int i = 0; i < 8; ++i) a[r][8 + i] = t[i];
            mk[r] = (unsigned)__ballot(sel[r] >= 0) & 0xffffu; }
        constexpr int NI = 3;
        { v2u y0[NI][R], y1[NI][R];
#pragma unroll
          for (int it = 0; it < NI; ++it)
#pragma unroll
            for (int r = 0; r < R; ++r) {
                const bool h = mk[r] != 0u; const int e = h ? __builtin_ctz(mk[r]) : 0; const int sl = __builtin_amdgcn_readlane(sel[r], e); mk[r] &= mk[r] - 1u;
                y0[it][r] = (v2u){0u, 0u}; y1[it][r] = y0[it][r];
                if (h) { const unsigned char* yr = Y + (((size_t)e * NB + b) * CAP + sl) * DM + 8 * lane; y0[it][r] = *(const v2u*)yr; y1[it][r] = *(const v2u*)(yr + 512); }
            }
#pragma unroll
          for (int it = 0; it < NI; ++it)
#pragma unroll
            for (int r = 0; r < R; ++r) { float t[8]; unpack8_fp8(y0[it][r], t);
#pragma unroll
                for (int i = 0; i < 8; ++i) a[r][i] += t[i] * (1.0f / pg8::YSCALE);
                unpack8_fp8(y1[it][r], t);
#pragma unroll
                for (int i = 0; i < 8; ++i) a[r][8 + i] += t[i] * (1.0f / pg8::YSCALE); } }
        while (mk[0] | mk[1] | mk[2] | mk[3]) {
            v2u y0[R], y1[R];
#pragma unroll
            for (int r = 0; r < R; ++r) {
                const bool h = mk[r] != 0u; const int e = h ? __builtin_ctz(mk[r]) : 0; const int sl = __builtin_amdgcn_readlane(sel[r], e); mk[r] &= mk[r] - 1u;
                y0[r] = (v2u){0u, 0u}; y1[r] = y0[r];
                if (h) { const unsigned char* yr = Y + (((size_t)e * NB + b) * CAP + sl) * DM + 8 * lane; y0[r] = *(const v2u*)yr; y1[r] = *(const v2u*)(yr + 512); }
            }
#pragma unroll
            for (int r = 0; r < R; ++r) { float t[8]; unpack8_fp8(y0[r], t);
#pragma unroll
                for (int i = 0; i < 8; ++i) a[r][i] += t[i] * (1.0f / pg8::YSCALE);
                unpack8_fp8(y1[r], t);
#pragma unroll
                for (int i = 0; i < 8; ++i) a[r][8 + i] += t[i] * (1.0f / pg8::YSCALE); }
        }
#pragma unroll
        for (int r = 0; r < R; ++r) {
            float (&v)[16] = a[r]; const int row = row0 + r;
            if (fout) { float* o = fout + (size_t)row * DM + 8 * lane;
                *(f32x4*)o = (f32x4){v[0], v[1], v[2], v[3]}; *(f32x4*)(o + 4) = (f32x4){v[4], v[5], v[6], v[7]}; *(f32x4*)(o + 512) = (f32x4){v[8], v[9], v[10], v[11]}; *(f32x4*)(o + 516) = (f32x4){v[12], v[13], v[14], v[15]}; }
            else {
                bf16* xo = x + (size_t)row * DM + 8 * lane;
                { float t[8];
#pragma unroll
                  for (int i = 0; i < 8; ++i) t[i] = v[i];
                  *(v4u*)xo = pack8(t);
#pragma unroll
                  for (int i = 0; i < 8; ++i) t[i] = v[8 + i];
                  *(v4u*)(xo + 512) = pack8(t); }
                float ss = 0.f;
#pragma unroll
                for (int i = 0; i < 16; ++i) ss += v[i] * v[i];
                const float rstd = 1.0f / sqrtf(wave_sum(ss) * (1.f / DM) + RMS_EPS);
                const f32x4 g0 = *(const f32x4*)(g + 8 * lane), g1 = *(const f32x4*)(g + 8 * lane + 4), g2 = *(const f32x4*)(g + 512 + 8 * lane), g3 = *(const f32x4*)(g + 516 + 8 * lane);
                unsigned char* o = (unsigned char*)XN + (size_t)row * DM + 8 * lane;
                *(v2u*)o = (v2u){pg8::pk4_fp8(v[0] * rstd * g0.x, v[1] * rstd * g0.y, v[2] * rstd * g0.z, v[3] * rstd * g0.w), pg8::pk4_fp8(v[4] * rstd * g1.x, v[5] * rstd * g1.y, v[6] * rstd * g1.z, v[7] * rstd * g1.w)};
                *(v2u*)(o + 512) = (v2u){pg8::pk4_fp8(v[8] * rstd * g2.x, v[9] * rstd * g2.y, v[10] * rstd * g2.z, v[11] * rstd * g2.w), pg8::pk4_fp8(v[12] * rstd * g3.x, v[13] * rstd * g3.y, v[14] * rstd * g3.z, v[15] * rstd * g3.w)};
            }
        }
    }
}

__device__ __forceinline__ int t5_bucket(int rel) {
    const int n = rel < 0 ? -rel : rel; int b = rel > 0 ? 16 : 0;
    if (n < 8) return b + n;
    b += 8 + (n >= 15) + (n >= 27) + (n >= 50) + (n >= 91) + (n >= 166) + (n >= 305) + (n >= 559);
    return b;
}
typedef short v4i16_t __attribute__((ext_vector_type(4)));
constexpr float KAPPA = 128.0f / 65535.0f, KAPPA_INV = 65535.0f / 128.0f;
__device__ __forceinline__ float xhalf_max(float x) { const auto rr = __builtin_amdgcn_permlane32_swap(__float_as_uint(x), __float_as_uint(x), false, false); return fmaxf(__uint_as_float(rr[0]), __uint_as_float(rr[1])); }
__device__ __forceinline__ float xhalf_sum(float x) { const auto rr = __builtin_amdgcn_permlane32_swap(__float_as_uint(x), __float_as_uint(x), false, false); return __uint_as_float(rr[0]) + __uint_as_float(rr[1]); }
__device__ __forceinline__ void band_branch(f32x16& o0, f32x16& o1, float& m, float& l, const bf16x8 (&qf)[4],
        const bf16* Kb, int kpitch, const bf16* Vb, int vpitch, int dil, int res, int L, int kb_first, int ntiles,
        const LAS float* tab, int tboff, LAS unsigned char* vst, int lane, float unscale = 1.0f) {
    int kt_lo = 0, kt_hi = ntiles;
    if (kb_first < 0) kt_lo = (-kb_first) >> 5;
    { const int mx = (L - kb_first) >> 5; if (mx < kt_hi) kt_hi = mx; }
    const int i5 = lane & 31, hh = lane >> 5;
    const int pi = (i5 & 0x13) | (((i5 >> 2) & 1) << 3) | (((i5 >> 3) & 1) << 2);
    const int vr = lane >> 3, vc = lane & 7;
    LAS unsigned char* kst = vst + 4096;
    const LAS unsigned char* trb = vst + (8 * hh + ((lane & 15) >> 2)) * 128 + (16 * ((lane >> 4) & 1) + 4 * (lane & 3)) * 2;
    const LAS unsigned char* krd = kst + pi * 128;
    v4u kn[4], vn[4];
#define BA_LOAD(kn, vn, kt_) do { const int kb_ = kb_first + 32 * (kt_); \
        _Pragma("unroll") for (int ii = 0; ii < 4; ++ii) { const size_t row_ = (size_t)(res + dil * (kb_ + vr + 8 * ii)); \
            kn[ii] = *(const v4u*)(Kb + row_ * kpitch + 8 * vc); vn[ii] = *(const v4u*)(Vb + row_ * vpitch + 8 * vc); } } while (0)
#define BA_TR(off_) __builtin_bit_cast(s16x4, __builtin_amdgcn_ds_read_tr16_b64_v4i16((LAS v4i16_t*)(trb + (off_))))
#define BA_VF(i_) (bf16x8){vt[i_][0], vt[i_][1], vt[i_][2], vt[i_][3], vt[(i_) + 1][0], vt[(i_) + 1][1], vt[(i_) + 1][2], vt[(i_) + 1][3]}
    if (kt_lo < kt_hi) BA_LOAD(kn, vn, kt_lo);
    for (int kt = kt_lo; kt < kt_hi; ++kt) {
#pragma unroll
        for (int ii = 0; ii < 4; ++ii) { const int r_ = vr + 8 * ii; *(LAS v4u*)(kst + r_ * 128 + ((vc ^ (r_ & 7)) * 16)) = kn[ii]; *(LAS v4u*)(vst + r_ * 128 + vc * 16) = vn[ii]; }
        if (kt + 1 < kt_hi) BA_LOAD(kn, vn, kt + 1);
        bf16x8 kf[4];
#pragma unroll
        for (int d0 = 0; d0 < 4; ++d0) kf[d0] = *(const LAS bf16x8*)(krd + (((2 * d0 + hh) ^ (pi & 7)) * 16));
        const LAS float* tp = tab + (kb_first + 32 * kt + tboff);
        f32x16 s;
#pragma unroll
        for (int r = 0; r < 16; ++r) s[r] = tp[(r & 7) + 16 * (r >> 3)];
        s16x4 vt[8];
#pragma unroll
        for (int i = 0; i < 8; ++i) vt[i] = BA_TR((i >> 2) * 2048 + ((i >> 1) & 1) * 64 + (i & 1) * 512);
        __builtin_amdgcn_sched_barrier(0);
#pragma unroll
        for (int d0 = 0; d0 < 4; ++d0) s = __builtin_amdgcn_mfma_f32_32x32x16_bf16(kf[d0], qf[d0], s, 0, 0, 0);
        __builtin_amdgcn_sched_barrier(0);
        if (unscale != 1.0f) {
#pragma unroll
            for (int r = 0; r < 16; ++r) s[r] *= unscale; }
        float mx = fmaxf(s[0], s[1]);
#pragma unroll
        for (int r = 2; r < 16; ++r) mx = fmaxf(mx, s[r]);
        mx = xhalf_max(mx);
        if (__any(mx > m)) {
            const float mn = fmaxf(m, mx), f = __builtin_amdgcn_exp2f(m - mn); m = mn; l *= f;
#pragma unroll
            for (int r = 0; r < 16; ++r) { o0[r] *= f; o1[r] *= f; }
        }
        float ps = 0.f;
#pragma unroll
        for (int r = 0; r < 16; ++r) { s[r] = __builtin_amdgcn_exp2f(s[r] - m); ps += s[r]; }
        l += ps;
        v4u p0, p1;
        p0.x = pkbf(s[0], s[1]); p0.y = pkbf(s[2], s[3]); p0.z = pkbf(s[4], s[5]); p0.w = pkbf(s[6], s[7]);
        p1.x = pkbf(s[8], s[9]); p1.y = pkbf(s[10], s[11]); p1.z = pkbf(s[12], s[13]); p1.w = pkbf(s[14], s[15]);
        const bf16x8 pk0 = __builtin_bit_cast(bf16x8, p0), pk1 = __builtin_bit_cast(bf16x8, p1);
        o0 = __builtin_amdgcn_mfma_f32_32x32x16_bf16(BA_VF(0), pk0, o0, 0, 0, 0); o1 = __builtin_amdgcn_mfma_f32_32x32x16_bf16(BA_VF(2), pk0, o1, 0, 0, 0);
        o0 = __builtin_amdgcn_mfma_f32_32x32x16_bf16(BA_VF(4), pk1, o0, 0, 0, 0); o1 = __builtin_amdgcn_mfma_f32_32x32x16_bf16(BA_VF(6), pk1, o1, 0, 0, 0);
    }
#undef BA_VF
#undef BA_TR
#undef BA_LOAD
}
__device__ __forceinline__ void band_branch_fast(f32x16& o0, f32x16& o1, f32x4& lsum, unsigned& orw, const bf16x8 (&qf)[4],
        const bf16* Kb, int kpitch, const bf16* Vb, int vpitch, int dil, int res, int L, int kb_first, int ntiles,
        const LAS float* tab, int tboff, LAS unsigned char* vst, int lane) {
    const unsigned one2 = ((lane & 15) == ((lane >> 4) & 1)) ? 0x3F803F80u : 0u;
    const bf16x8 onesA = __builtin_bit_cast(bf16x8, (v4u){one2, one2, one2, one2});
    int kt_lo = 0, kt_hi = ntiles;
    if (kb_first < 0) kt_lo = (-kb_first) >> 5;
    { const int mx = (L - kb_first) >> 5; if (mx < kt_hi) kt_hi = mx; }
    const int i5 = lane & 31, hh = lane >> 5;
    const int pi = (i5 & 0x13) | (((i5 >> 2) & 1) << 3) | (((i5 >> 3) & 1) << 2);
    const int vr = lane >> 3, vc = lane & 7;
    LAS unsigned char* kst = vst + 4096;
    const LAS unsigned char* trb = vst + (8 * hh + ((lane & 15) >> 2)) * 128 + (16 * ((lane >> 4) & 1) + 4 * (lane & 3)) * 2;
    const LAS unsigned char* krd = kst + pi * 128;
    v4u kn[4], vn[4];
#define BA_LOAD(kn, vn, kt_) do { const int kb_ = kb_first + 32 * (kt_); \
        _Pragma("unroll") for (int ii = 0; ii < 4; ++ii) { const size_t row_ = (size_t)(res + dil * (kb_ + vr + 8 * ii)); \
            kn[ii] = *(const v4u*)(Kb + row_ * kpitch + 8 * vc); vn[ii] = *(const v4u*)(Vb + row_ * vpitch + 8 * vc); } } while (0)
#define BA_TR(off_) __builtin_bit_cast(s16x4, __builtin_amdgcn_ds_read_tr16_b64_v4i16((LAS v4i16_t*)(trb + (off_))))
#define BA_VF(i_) (bf16x8){vt[i_][0], vt[i_][1], vt[i_][2], vt[i_][3], vt[(i_) + 1][0], vt[(i_) + 1][1], vt[(i_) + 1][2], vt[(i_) + 1][3]}
    if (kt_lo < kt_hi) BA_LOAD(kn, vn, kt_lo);
    for (int kt = kt_lo; kt < kt_hi; ++kt) {
#pragma unroll
        for (int ii = 0; ii < 4; ++ii) { const int r_ = vr + 8 * ii; *(LAS v4u*)(kst + r_ * 128 + ((vc ^ (r_ & 7)) * 16)) = kn[ii]; *(LAS v4u*)(vst + r_ * 128 + vc * 16) = vn[ii]; }
        if (kt + 1 < kt_hi) BA_LOAD(kn, vn, kt + 1);
        bf16x8 kf[4];
#pragma unroll
        for (int d0 = 0; d0 < 4; ++d0) kf[d0] = *(const LAS bf16x8*)(krd + (((2 * d0 + hh) ^ (pi & 7)) * 16));
        const LAS float* tp = tab + (kb_first + 32 * kt + tboff);
        f32x16 s;
#pragma unroll
        for (int r = 0; r < 16; ++r) s[r] = tp[(r & 7) + 16 * (r >> 3)];
        s16x4 vt[8];
#pragma unroll
        for (int i = 0; i < 8; ++i) vt[i] = BA_TR((i >> 2) * 2048 + ((i >> 1) & 1) * 64 + (i & 1) * 512);
        __builtin_amdgcn_sched_barrier(0);
#pragma unroll
        for (int d0 = 0; d0 < 4; ++d0) s = __builtin_amdgcn_mfma_f32_32x32x16_bf16(kf[d0], qf[d0], s, 0, 0, 0);
        __builtin_amdgcn_sched_barrier(0);
        v4u p0, p1;
#define BA_PKN(a_, b_) __builtin_bit_cast(unsigned, __builtin_amdgcn_cvt_pknorm_u16((a_), (b_)))
        p0.x = BA_PKN(s[0], s[1]); p0.y = BA_PKN(s[2], s[3]); p0.z = BA_PKN(s[4], s[5]); p0.w = BA_PKN(s[6], s[7]);
        p1.x = BA_PKN(s[8], s[9]); p1.y = BA_PKN(s[10], s[11]); p1.z = BA_PKN(s[12], s[13]); p1.w = BA_PKN(s[14], s[15]);
#undef BA_PKN
        orw |= (p0.x | p0.y | p0.z) | (p0.w | p1.x | p1.y) | (p1.z | p1.w);
        const bf16x8 pk0 = __builtin_bit_cast(bf16x8, p0), pk1 = __builtin_bit_cast(bf16x8, p1);
        lsum = __builtin_amdgcn_mfma_f32_16x16x32_bf16(onesA, pk0, lsum, 0, 0, 0); lsum = __builtin_amdgcn_mfma_f32_16x16x32_bf16(onesA, pk1, lsum, 0, 0, 0);
        o0 = __builtin_amdgcn_mfma_f32_32x32x16_bf16(BA_VF(0), pk0, o0, 0, 0, 0); o1 = __builtin_amdgcn_mfma_f32_32x32x16_bf16(BA_VF(2), pk0, o1, 0, 0, 0);
        o0 = __builtin_amdgcn_mfma_f32_32x32x16_bf16(BA_VF(4), pk1, o0, 0, 0, 0); o1 = __builtin_amdgcn_mfma_f32_32x32x16_bf16(BA_VF(6), pk1, o1, 0, 0, 0);
    }
#undef BA_VF
#undef BA_TR
#undef BA_LOAD
}
__device__ __forceinline__ void band_store(const f32x16& o0, const f32x16& o1, float l, unsigned char* orow  , int lane) {
    const float lt = xhalf_sum(l), inv = attn_body::OSCALE / lt; const int hh = lane >> 5;
#pragma unroll
    for (int g = 0; g < 4; ++g) {
        *(unsigned*)(orow + 8 * g + 4 * hh) = pg8::pk4_fp8(pg8::clamp448(o0[4 * g] * inv), pg8::clamp448(o0[4 * g + 1] * inv), pg8::clamp448(o0[4 * g + 2] * inv), pg8::clamp448(o0[4 * g + 3] * inv));
        *(unsigned*)(orow + 32 + 8 * g + 4 * hh) = pg8::pk4_fp8(pg8::clamp448(o1[4 * g] * inv), pg8::clamp448(o1[4 * g + 1] * inv), pg8::clamp448(o1[4 * g + 2] * inv), pg8::clamp448(o1[4 * g + 3] * inv)); }
}
constexpr int TA_LEN = 1280, TA_OFF = 512, TC_LEN = 384, TC_OFF = 32, BAND_TAB_BYTES = 16384, BAND_VST_OFF = 16384;
__device__ __forceinline__ void band_state_store(const f32x16& o0, const f32x16& o1, float m, float l, float* st, float* ml, int lane) {
    const float lt = xhalf_sum(l); const int hh = lane >> 5;
    bf16* sb = (bf16*)st;
#pragma unroll
    for (int g = 0; g < 4; ++g) { *(v2u*)(sb + 8 * g + 4 * hh) = (v2u){pkbf(o0[4 * g], o0[4 * g + 1]), pkbf(o0[4 * g + 2], o0[4 * g + 3])}; *(v2u*)(sb + 32 + 8 * g + 4 * hh) = (v2u){pkbf(o1[4 * g], o1[4 * g + 1]), pkbf(o1[4 * g + 2], o1[4 * g + 3])}; }
    if (hh == 0) *(f32x2*)ml = (f32x2){m, lt};
}
__device__ __forceinline__ void band_state_load(f32x16& o0, f32x16& o1, float& m, float& l, const float* st, const float* ml, int lane) {
    const int hh = lane >> 5;
    const bf16* sb = (const bf16*)st;
#pragma unroll
    for (int g = 0; g < 4; ++g) { const v2u a = *(const v2u*)(sb + 8 * g + 4 * hh), b = *(const v2u*)(sb + 32 + 8 * g + 4 * hh);
        o0[4 * g] = bf_lo(a.x); o0[4 * g + 1] = bf_hi(a.x); o0[4 * g + 2] = bf_lo(a.y); o0[4 * g + 3] = bf_hi(a.y); o1[4 * g] = bf_lo(b.x); o1[4 * g + 1] = bf_hi(b.x); o1[4 * g + 2] = bf_lo(b.y); o1[4 * g + 3] = bf_hi(b.y); }
    const f32x2 v = *(const f32x2*)ml; m = v.x; l = (hh == 0) ? v.y : 0.f;
}
__device__ __forceinline__ void mixer_a_phase(const bf16* AQ, const bf16* AK, const bf16* AV  , bf16* O, float* ST, float* ML, const float* rel_bias, LAS unsigned char* lds, int G, int blk, int tid, int lane, int wave) {
    LAS float* tab = (LAS float*)lds; LAS unsigned char* vst = lds + BAND_VST_OFF + wave * 8192;
    constexpr float M_FAST = 127.0f;
    int cur_h = -1;
    for (int u = blk; u < 512; u += G) {
        const int h = u & 7, v = u >> 3, b = v >> 4, a = v & 15;
        if (h != cur_h) {
            __syncthreads();
            for (int idx = tid; idx < 3 * TA_LEN; idx += NWAVES * 64) { const int br = idx / TA_LEN, i = idx % TA_LEN - TA_OFF, dil = br == 0 ? 1 : (br == 1 ? 4 : 16);
                tab[idx] = (i >= 0 && i <= 128) ? (rel_bias[h * 32 + t5_bucket((i - 64) * dil)] * LOG2E + 64.0f) * KAPPA : -1.0f; }
            __syncthreads(); cur_h = h;
        }
        const int i5 = lane & 31, hh = lane >> 5;
        const size_t tb0 = (size_t)b * SEQ;
        const bf16* Kb = AK + tb0 * 512 + h * 64; const bf16* Vb = AV + tb0 * 512 + h * 64;
        bf16x8 qn[4];
        { const bf16* qp = AQ + (tb0 + 512 * a + 32 * wave + i5) * 512 + h * 64 + 8 * hh;
#pragma unroll
          for (int d0 = 0; d0 < 4; ++d0) qn[d0] = *(const bf16x8*)(qp + 16 * d0); }
#pragma unroll 1
        for (int tile = wave; tile < 16; tile += NWAVES) {
            const int q0 = 512 * a + 32 * tile, tq = q0 + i5;
            bf16x8 qf[4];
#pragma unroll
            for (int d0 = 0; d0 < 4; ++d0) qf[d0] = qn[d0];
            { const bool more = tile + NWAVES < 16; const bf16* qp = more ? AQ + (tb0 + tq + 32 * NWAVES) * 512 + h * 64 + 8 * hh : AQ + (tb0 + 512 * a + 16 * i5 + wave) * 512 + h * 64 + 8 * hh;
#pragma unroll
              for (int d0 = 0; d0 < 4; ++d0) qn[d0] = *(const bf16x8*)(qp + 16 * d0); }
            f32x16 o0 = {}, o1 = {}; f32x4 lsum = {0.f, 0.f, 0.f, 0.f}; unsigned orw = 0u; float m = M_FAST, l;
            band_branch_fast(o0, o1, lsum, orw, qf, Kb, 512, Vb, 512, 1, 0, SEQ, q0 - 64, 5, tab, -tq + 64 + TA_OFF + 8 * hh, vst, lane);
            { const float la = __shfl(lsum[0], i5 & 15), lb = __shfl(lsum[1], i5 & 15); const float lt = (i5 & 16) ? lb : la;
              l = (hh == 0) ? lt : 0.0f;
              if (__builtin_expect(__any(((orw & 0xC000C000u) != 0u) || !(lt > 1.0e-30f)), 0)) {
                  o0 = f32x16{}; o1 = f32x16{}; m = NEGBIG; l = 0.f;
                  band_branch(o0, o1, m, l, qf, Kb, 512, Vb, 512, 1, 0, SEQ, q0 - 64, 5, tab, -tq + 64 + TA_OFF + 8 * hh, vst, lane, KAPPA_INV); } }
            band_state_store(o0, o1, m, l, ST + ((tb0 + tq) * 8 + h) * 64, ML + ((tb0 + tq) * 8 + h) * 2, lane);
        }
        asm volatile("s_waitcnt vmcnt(0)" ::: "memory");
        __syncthreads();
#pragma unroll 1
        for (int r = wave; r < 16; r += NWAVES) {
            const int tq = 512 * a + 16 * i5 + r;
            bf16x8 qf[4];
#pragma unroll
            for (int d0 = 0; d0 < 4; ++d0) qf[d0] = qn[d0];
            if (r + NWAVES < 16) { const bf16* qp = AQ + (tb0 + tq + NWAVES) * 512 + h * 64 + 8 * hh;
#pragma unroll
              for (int d0 = 0; d0 < 4; ++d0) qn[d0] = *(const bf16x8*)(qp + 16 * d0); }
            f32x16 o0, o1; float m, l;
            band_state_load(o0, o1, m, l, ST + ((tb0 + tq) * 8 + h) * 64, ML + ((tb0 + tq) * 8 + h) * 2, lane);
            bool exact = __any(m != M_FAST);
            if (__builtin_expect(!exact, 1)) {
                f32x4 lsum = {0.f, 0.f, 0.f, 0.f}; unsigned orw = 0u;
                band_branch_fast(o0, o1, lsum, orw, qf, Kb, 512, Vb, 512, 16, r, 512, 32 * (a - 2), 5, tab + 2 * TA_LEN, -(32 * a + i5) + 64 + TA_OFF + 8 * hh, vst, lane);
                band_branch_fast(o0, o1, lsum, orw, qf, Kb, 512, Vb, 512, 4, r & 3, 2048, 128 * a - 64, 8, tab + TA_LEN, -(128 * a + 4 * i5 + (r >> 2)) + 64 + TA_OFF + 8 * hh, vst, lane);
                const float la = __shfl(lsum[0], i5 & 15), lb = __shfl(lsum[1], i5 & 15); const float lt = (i5 & 16) ? lb : la;
                const float l1 = xhalf_sum(l);
                if (__builtin_expect(__any(((orw & 0xC000C000u) != 0u) || !(l1 + lt > 1.0e-30f)), 0)) { exact = true; band_state_load(o0, o1, m, l, ST + ((tb0 + tq) * 8 + h) * 64, ML + ((tb0 + tq) * 8 + h) * 2, lane); }
                else l = (hh == 0) ? (l1 + lt) : 0.0f;
            }
            if (__builtin_expect(exact, 0)) {
                band_branch(o0, o1, m, l, qf, Kb, 512, Vb, 512, 16, r, 512, 32 * (a - 2), 5, tab + 2 * TA_LEN, -(32 * a + i5) + 64 + TA_OFF + 8 * hh, vst, lane, KAPPA_INV);
                band_branch(o0, o1, m, l, qf, Kb, 512, Vb, 512, 4, r & 3, 2048, 128 * a - 64, 8, tab + TA_LEN, -(128 * a + 4 * i5 + (r >> 2)) + 64 + TA_OFF + 8 * hh, vst, lane, KAPPA_INV);
            }
            band_store(o0, o1, l, (unsigned char*)O + (size_t)(tb0 + tq) * 1024 + h * 64, lane);
        }
    }
}
__device__ __forceinline__ void band_branch_shared(f32x16& o0, f32x16& o1, float& m, float& l, const bf16x8 (&qf)[4],
        const LAS unsigned char* kimg, const LAS unsigned char* vimg, int rw0, int L, int kb_first, int ntiles, const LAS float* tab, int tboff, int lane, float unscale = 1.0f) {
    int kt_lo = 0, kt_hi = ntiles;
    if (kb_first < 0) kt_lo = (-kb_first) >> 5;
    { const int mx = (L - kb_first) >> 5; if (mx < kt_hi) kt_hi = mx; }
    const int i5 = lane & 31, hh = lane >> 5;
    const int pi = (i5 & 0x13) | (((i5 >> 2) & 1) << 3) | (((i5 >> 3) & 1) << 2);
    const LAS unsigned char* trb = vimg + (rw0 + 8 * hh + ((lane & 15) >> 2)) * 128 + (16 * ((lane >> 4) & 1) + 4 * (lane & 3)) * 2;
    const LAS unsigned char* krd = kimg + (rw0 + pi) * 128;
#define BA_TR(off_) __builtin_bit_cast(s16x4, __builtin_amdgcn_ds_read_tr16_b64_v4i16((LAS v4i16_t*)(trb + (off_))))
#define BA_VF(vt, i_) (bf16x8){vt[i_][0], vt[i_][1], vt[i_][2], vt[i_][3], vt[(i_) + 1][0], vt[(i_) + 1][1], vt[(i_) + 1][2], vt[(i_) + 1][3]}
#define BA_FETCH(kf, s, vt, kt_) do { const int tb_ = (kt_) * 4096; \
        _Pragma("unroll") for (int d0 = 0; d0 < 4; ++d0) kf[d0] = *(const LAS bf16x8*)(krd + tb_ + (((2 * d0 + hh) ^ (pi & 7)) * 16)); \
        const LAS float* tp_ = tab + (kb_first + 32 * (kt_) + tboff); \
        _Pragma("unroll") for (int r = 0; r < 16; ++r) s[r] = tp_[(r & 7) + 16 * (r >> 3)]; \
        _Pragma("unroll") for (int i = 0; i < 8; ++i) vt[i] = BA_TR(tb_ + (i >> 2) * 2048 + ((i >> 1) & 1) * 64 + (i & 1) * 512); } while (0)
#define BA_PACK(p0, p1, s) do { p0.x = pkbf(s[0], s[1]); p0.y = pkbf(s[2], s[3]); p0.z = pkbf(s[4], s[5]); p0.w = pkbf(s[6], s[7]); \
        p1.x = pkbf(s[8], s[9]); p1.y = pkbf(s[10], s[11]); p1.z = pkbf(s[12], s[13]); p1.w = pkbf(s[14], s[15]); } while (0)
    int kt = kt_lo;
    for (; kt + 1 < kt_hi; kt += 2) {
        bf16x8 kfa[4], kfb[4]; f32x16 sa, sb; s16x4 vta[8], vtb[8];
        BA_FETCH(kfa, sa, vta, kt); BA_FETCH(kfb, sb, vtb, kt + 1);
        __builtin_amdgcn_sched_barrier(0);
#pragma unroll
        for (int d0 = 0; d0 < 4; ++d0) { sa = __builtin_amdgcn_mfma_f32_32x32x16_bf16(kfa[d0], qf[d0], sa, 0, 0, 0); sb = __builtin_amdgcn_mfma_f32_32x32x16_bf16(kfb[d0], qf[d0], sb, 0, 0, 0); }
        __builtin_amdgcn_sched_barrier(0);
        if (unscale != 1.0f) {
#pragma unroll
            for (int r = 0; r < 16; ++r) { sa[r] *= unscale; sb[r] *= unscale; } }
        float mx = fmaxf(sa[0], sb[0]);
#pragma unroll
        for (int r = 1; r < 16; ++r) mx = fmaxf(mx, fmaxf(sa[r], sb[r]));
        mx = xhalf_max(mx);
        if (__any(mx > m)) {
            const float mn = fmaxf(m, mx), f = __builtin_amdgcn_exp2f(m - mn); m = mn; l *= f;
#pragma unroll
            for (int r = 0; r < 16; ++r) { o0[r] *= f; o1[r] *= f; }
        }
        float ps = 0.f;
#pragma unroll
        for (int r = 0; r < 16; ++r) { sa[r] = __builtin_amdgcn_exp2f(sa[r] - m); sb[r] = __builtin_amdgcn_exp2f(sb[r] - m); ps += sa[r] + sb[r]; }
        l += ps;
        v4u pa0, pa1, pb0, pb1; BA_PACK(pa0, pa1, sa); BA_PACK(pb0, pb1, sb);
        const bf16x8 ka0 = __builtin_bit_cast(bf16x8, pa0), ka1 = __builtin_bit_cast(bf16x8, pa1), kb0 = __builtin_bit_cast(bf16x8, pb0), kb1 = __builtin_bit_cast(bf16x8, pb1);
        o0 = __builtin_amdgcn_mfma_f32_32x32x16_bf16(BA_VF(vta, 0), ka0, o0, 0, 0, 0); o1 = __builtin_amdgcn_mfma_f32_32x32x16_bf16(BA_VF(vta, 2), ka0, o1, 0, 0, 0);
        o0 = __builtin_amdgcn_mfma_f32_32x32x16_bf16(BA_VF(vta, 4), ka1, o0, 0, 0, 0); o1 = __builtin_amdgcn_mfma_f32_32x32x16_bf16(BA_VF(vta, 6), ka1, o1, 0, 0, 0);
        o0 = __builtin_amdgcn_mfma_f32_32x32x16_bf16(BA_VF(vtb, 0), kb0, o0, 0, 0, 0); o1 = __builtin_amdgcn_mfma_f32_32x32x16_bf16(BA_VF(vtb, 2), kb0, o1, 0, 0, 0);
        o0 = __builtin_amdgcn_mfma_f32_32x32x16_bf16(BA_VF(vtb, 4), kb1, o0, 0, 0, 0); o1 = __builtin_amdgcn_mfma_f32_32x32x16_bf16(BA_VF(vtb, 6), kb1, o1, 0, 0, 0);
    }
    if (kt < kt_hi) {
        bf16x8 kfa[4]; f32x16 sa; s16x4 vta[8];
        BA_FETCH(kfa, sa, vta, kt);
        __builtin_amdgcn_sched_barrier(0);
#pragma unroll
        for (int d0 = 0; d0 < 4; ++d0) sa = __builtin_amdgcn_mfma_f32_32x32x16_bf16(kfa[d0], qf[d0], sa, 0, 0, 0);
        __builtin_amdgcn_sched_barrier(0);
        if (unscale != 1.0f) {
#pragma unroll
            for (int r = 0; r < 16; ++r) sa[r] *= unscale; }
        float mx = fmaxf(sa[0], sa[1]);
#pragma unroll
        for (int r = 2; r < 16; ++r) mx = fmaxf(mx, sa[r]);
        mx = xhalf_max(mx);
        if (__any(mx > m)) {
            const float mn = fmaxf(m, mx), f = __builtin_amdgcn_exp2f(m - mn); m = mn; l *= f;
#pragma unroll
            for (int r = 0; r < 16; ++r) { o0[r] *= f; o1[r] *= f; }
        }
        float ps = 0.f;
#pragma unroll
        for (int r = 0; r < 16; ++r) { sa[r] = __builtin_amdgcn_exp2f(sa[r] - m); ps += sa[r]; }
        l += ps;
        v4u pa0, pa1; BA_PACK(pa0, pa1, sa);
        const bf16x8 ka0 = __builtin_bit_cast(bf16x8, pa0), ka1 = __builtin_bit_cast(bf16x8, pa1);
        o0 = __builtin_amdgcn_mfma_f32_32x32x16_bf16(BA_VF(vta, 0), ka0, o0, 0, 0, 0); o1 = __builtin_amdgcn_mfma_f32_32x32x16_bf16(BA_VF(vta, 2), ka0, o1, 0, 0, 0);
        o0 = __builtin_amdgcn_mfma_f32_32x32x16_bf16(BA_VF(vta, 4), ka1, o0, 0, 0, 0); o1 = __builtin_amdgcn_mfma_f32_32x32x16_bf16(BA_VF(vta, 6), ka1, o1, 0, 0, 0);
    }
#undef BA_PACK
#undef BA_FETCH
#undef BA_VF
#undef BA_TR
}
__device__ __forceinline__ void band_branch_shared_fast(f32x16& o0, f32x16& o1, f32x4& lsum, unsigned& orw, const bf16x8 (&qf)[4],
        const LAS unsigned char* kimg, const LAS unsigned char* vimg, int rw0, int L, int kb_first, int ntiles, const LAS float* tab, int tboff, int lane) {
    int kt_lo = 0, kt_hi = ntiles;
    if (kb_first < 0) kt_lo = (-kb_first) >> 5;
    { const int mx = (L - kb_first) >> 5; if (mx < kt_hi) kt_hi = mx; }
    const int i5 = lane & 31, hh = lane >> 5;
    const int pi = (i5 & 0x13) | (((i5 >> 2) & 1) << 3) | (((i5 >> 3) & 1) << 2);
    const LAS unsigned char* trb = vimg + (rw0 + 8 * hh + ((lane & 15) >> 2)) * 128 + (16 * ((lane >> 4) & 1) + 4 * (lane & 3)) * 2;
    const LAS unsigned char* krd = kimg + (rw0 + pi) * 128;
    { unsigned a_ = (unsigned)(size_t)trb, b_ = (unsigned)(size_t)krd; asm volatile("" : "+v"(a_), "+v"(b_)); trb = (const LAS unsigned char*)(size_t)a_; krd = (const LAS unsigned char*)(size_t)b_; }
    const unsigned one2 = ((lane & 15) == ((lane >> 4) & 1)) ? 0x3F803F80u : 0u;
    const bf16x8 onesA = __builtin_bit_cast(bf16x8, (v4u){one2, one2, one2, one2});
#define BA_TR(off_) __builtin_bit_cast(s16x4, __builtin_amdgcn_ds_read_tr16_b64_v4i16((LAS v4i16_t*)(trb + (off_))))
#define BA_VF(vt, i_) (bf16x8){vt[i_][0], vt[i_][1], vt[i_][2], vt[i_][3], vt[(i_) + 1][0], vt[(i_) + 1][1], vt[(i_) + 1][2], vt[(i_) + 1][3]}
#define BA_FETCH(kf, s, vt, kt_) do { const int tb_ = (kt_) * 4096; \
        _Pragma("unroll") for (int d0 = 0; d0 < 4; ++d0) kf[d0] = *(const LAS bf16x8*)(krd + tb_ + (((2 * d0 + hh) ^ (pi & 7)) * 16)); \
        const LAS float* tp_ = tab + (kb_first + 32 * (kt_) + tboff); \
        _Pragma("unroll") for (int r = 0; r < 16; ++r) s[r] = tp_[(r & 7) + 16 * (r >> 3)]; \
        _Pragma("unroll") for (int i = 0; i < 8; ++i) vt[i] = BA_TR(tb_ + (i >> 2) * 2048 + ((i >> 1) & 1) * 64 + (i & 1) * 512); } while (0)
#define BA_PKN(a_, b_) __builtin_bit_cast(unsigned, __builtin_amdgcn_cvt_pknorm_u16((a_), (b_)))
#define BA_PACKN(p0, p1, s) do { p0.x = BA_PKN(s[0], s[1]); p0.y = BA_PKN(s[2], s[3]); p0.z = BA_PKN(s[4], s[5]); p0.w = BA_PKN(s[6], s[7]); \
        p1.x = BA_PKN(s[8], s[9]); p1.y = BA_PKN(s[10], s[11]); p1.z = BA_PKN(s[12], s[13]); p1.w = BA_PKN(s[14], s[15]); \
        orw |= (p0.x | p0.y | p0.z) | (p0.w | p1.x | p1.y) | (p1.z | p1.w); } while (0)
#define BA_TILE_PV(vt, k0, k1) do { lsum = __builtin_amdgcn_mfma_f32_16x16x32_bf16(onesA, k0, lsum, 0, 0, 0); lsum = __builtin_amdgcn_mfma_f32_16x16x32_bf16(onesA, k1, lsum, 0, 0, 0); \
        o0 = __builtin_amdgcn_mfma_f32_32x32x16_bf16(BA_VF(vt, 0), k0, o0, 0, 0, 0); o1 = __builtin_amdgcn_mfma_f32_32x32x16_bf16(BA_VF(vt, 2), k0, o1, 0, 0, 0); \
        o0 = __builtin_amdgcn_mfma_f32_32x32x16_bf16(BA_VF(vt, 4), k1, o0, 0, 0, 0); o1 = __builtin_amdgcn_mfma_f32_32x32x16_bf16(BA_VF(vt, 6), k1, o1, 0, 0, 0); } while (0)
    int kt = kt_lo;
    for (; kt + 1 < kt_hi; kt += 2) {
        bf16x8 kfa[4], kfb[4]; f32x16 sa, sb; s16x4 vta[8], vtb[8];
        BA_FETCH(kfa, sa, vta, kt); BA_FETCH(kfb, sb, vtb, kt + 1);
        __builtin_amdgcn_sched_barrier(0);
#pragma unroll
        for (int d0 = 0; d0 < 4; ++d0) { sa = __builtin_amdgcn_mfma_f32_32x32x16_bf16(kfa[d0], qf[d0], sa, 0, 0, 0); sb = __builtin_amdgcn_mfma_f32_32x32x16_bf16(kfb[d0], qf[d0], sb, 0, 0, 0); }
        __builtin_amdgcn_sched_barrier(0);
        v4u pa0, pa1, pb0, pb1; BA_PACKN(pa0, pa1, sa); BA_PACKN(pb0, pb1, sb);
        const bf16x8 ka0 = __builtin_bit_cast(bf16x8, pa0), ka1 = __builtin_bit_cast(bf16x8, pa1), kb0 = __builtin_bit_cast(bf16x8, pb0), kb1 = __builtin_bit_cast(bf16x8, pb1);
        BA_TILE_PV(vta, ka0, ka1); BA_TILE_PV(vtb, kb0, kb1);
    }
    if (kt < kt_hi) {
        bf16x8 kfa[4]; f32x16 sa; s16x4 vta[8];
        BA_FETCH(kfa, sa, vta, kt);
        __builtin_amdgcn_sched_barrier(0);
#pragma unroll
        for (int d0 = 0; d0 < 4; ++d0) sa = __builtin_amdgcn_mfma_f32_32x32x16_bf16(kfa[d0], qf[d0], sa, 0, 0, 0);
        __builtin_amdgcn_sched_barrier(0);
        v4u pa0, pa1; BA_PACKN(pa0, pa1, sa);
        const bf16x8 ka0 = __builtin_bit_cast(bf16x8, pa0), ka1 = __builtin_bit_cast(bf16x8, pa1);
        BA_TILE_PV(vta, ka0, ka1);
    }
#undef BA_TILE_PV
#undef BA_PACKN
#undef BA_PKN
#undef BA_FETCH
#undef BA_VF
#undef BA_TR
}
__device__ __forceinline__ void mixer_c_shared(const bf16* CQ, const bf16* CK, const bf16* CV  , bf16* O, const float* rel_bias, const float* sink, LAS unsigned char* lds, int G, int blk, int tid, int lane, int wave) {
    LAS float* tab4 = (LAS float*)lds; LAS unsigned char* kimg = lds + 6144; LAS unsigned char* vimg = lds + 6144 + 65536;
    static_assert(4 * TC_LEN * 4 <= 6144 && 6144 + 2 * 65536 <= SCR_BYTES, "mixer C LDS map");
    for (int su = blk; su < 512; su += G) {
        const int kvh = su & 3, v = su >> 2, b = v >> 5, q0 = 256 * (v & 31), w0 = q0 - 128;
        const size_t tb0 = (size_t)b * SEQ;
        const int i5 = lane & 31, hh = lane >> 5, q0w = q0 + 32 * wave, tq = q0w + i5;
        const bf16* qp = CQ + (tb0 + tq) * 1024 + (4 * kvh) * 64 + 8 * hh;
        bf16x8 qn[4];
#pragma unroll
        for (int d0 = 0; d0 < 4; ++d0) qn[d0] = *(const bf16x8*)(qp + 16 * d0);
        __syncthreads();
        for (int idx = tid; idx < TC_LEN; idx += NWAVES * 64) { const int i = idx - TC_OFF; const bool in = (i >= 0 && i <= 256); const int bk = in ? t5_bucket(i - 128) : 0;
#pragma unroll
            for (int j = 0; j < 4; ++j) tab4[j * TC_LEN + idx] = in ? (rel_bias[(4 * kvh + j) * 32 + bk] * LOG2E + 64.0f) * KAPPA : -1.0f; }
#pragma unroll
        for (int half = 0; half < 2; ++half) {
            v4u kv[4], vv[4];
#pragma unroll
            for (int i = 0; i < 4; ++i) { const int c = tid + 512 * (4 * half + i), rw = c >> 3, ch = c & 7, key = w0 + rw; const bool ok = key >= 0 && key < SEQ; const size_t ro = (tb0 + (ok ? key : 0)) * 256 + kvh * 64 + 8 * ch;
                kv[i] = *(const v4u*)(CK + ro); vv[i] = *(const v4u*)(CV + ro); }
#pragma unroll
            for (int i = 0; i < 4; ++i) { const int c = tid + 512 * (4 * half + i), rw = c >> 3, ch = c & 7;
                *(LAS v4u*)(kimg + rw * 128 + ((ch ^ (rw & 7)) * 16)) = kv[i]; *(LAS v4u*)(vimg + rw * 128 + ch * 16) = vv[i]; }
        }
        __syncthreads();
#pragma unroll 1
        for (int j = 0; j < 4; ++j) {
            const int h = 4 * kvh + j; const LAS float* tab = tab4 + j * TC_LEN;
            bf16x8 qf[4];
#pragma unroll
            for (int d0 = 0; d0 < 4; ++d0) qf[d0] = qn[d0];
            if (j < 3) {
#pragma unroll
                for (int d0 = 0; d0 < 4; ++d0) qn[d0] = *(const bf16x8*)(qp + 64 * (j + 1) + 16 * d0); }
            f32x16 o0 = {}, o1 = {}; f32x4 lsum = {0.f, 0.f, 0.f, 0.f}; unsigned orw = 0u; float l;
            band_branch_shared_fast(o0, o1, lsum, orw, qf, kimg, vimg, 32 * wave, SEQ, q0w - 128, 9, tab, -tq + 128 + TC_OFF + 8 * hh, lane);
            {
              const float xs = fminf(fmaxf((sink[h] * LOG2E + 64.0f) * 128.0f, 0.0f), 32767.0f); const float ps = __uint_as_float(((unsigned)__float2int_rn(xs)) << 16);
              const float la = __shfl(lsum[0], i5 & 15), lb = __shfl(lsum[1], i5 & 15); const float lt = ((i5 & 16) ? lb : la) + ps;
              l = (hh == 0) ? lt : 0.0f;
              const bool bad = ((orw & 0xC000C000u) != 0u) || !(lt > 1.0e-30f) || (sink[h] * LOG2E >= 63.0f);
              if (__builtin_expect(__any(bad), 0)) {
                  o0 = f32x16{}; o1 = f32x16{}; float m = sink[h] * LOG2E + 64.0f; l = (hh == 0) ? 1.0f : 0.0f;
                  band_branch_shared(o0, o1, m, l, qf, kimg, vimg, 32 * wave, SEQ, q0w - 128, 9, tab, -tq + 128 + TC_OFF + 8 * hh, lane, KAPPA_INV);
              } }
            band_store(o0, o1, l, (unsigned char*)O + (size_t)(tb0 + tq) * 1024 + h * 64, lane);
        }
    }
}
__device__ __forceinline__ void mixer_c_phase(const bf16* CQ, const bf16* CK, const bf16* CV  , bf16* O, const float* rel_bias, const float* sink, LAS unsigned char* lds, int G, int blk, int tid, int lane, int wave) {
    LAS float* tab = (LAS float*)lds; LAS unsigned char* vst = lds + BAND_VST_OFF + wave * 8192;
    int cur_h = -1;
    for (int u = blk; u < 2048; u += G) {
        const int h = u & 15, v = u >> 4, b = v >> 5, q0 = 256 * (v & 31) + 32 * wave;
        if (h != cur_h) {
            __syncthreads();
            for (int idx = tid; idx < TC_LEN; idx += NWAVES * 64) { const int i = idx - TC_OFF; tab[idx] = (i >= 0 && i <= 256) ? rel_bias[h * 32 + t5_bucket(i - 128)] * LOG2E : NEGBIG; }
            __syncthreads(); cur_h = h;
        }
        const int i5 = lane & 31, hh = lane >> 5;
        const size_t tb0 = (size_t)b * SEQ;
        const int tq = q0 + i5;
        const bf16* qp = CQ + (tb0 + tq) * 1024 + h * 64 + 8 * hh;
        bf16x8 qf[4];
#pragma unroll
        for (int d0 = 0; d0 < 4; ++d0) qf[d0] = *(const bf16x8*)(qp + 16 * d0);
        f32x16 o0 = {}, o1 = {}; float m = sink[h] * LOG2E, l = (hh == 0) ? 1.0f : 0.0f;
        const bf16* Kb = CK + tb0 * 256 + (h >> 2) * 64; const bf16* Vb = CV + tb0 * 256 + (h >> 2) * 64;
        band_branch(o0, o1, m, l, qf, Kb, 256, Vb, 256, 1, 0, SEQ, q0 - 128, 9, tab, -tq + 128 + TC_OFF + 8 * hh, vst, lane);
        band_store(o0, o1, l, (unsigned char*)O + (size_t)(tb0 + tq) * 1024 + h * 64, lane);
    }
}

struct Args { const float* in[25]; float* out; unsigned char* ws; int ph_lo, ph_hi; };
__global__ void __launch_bounds__(NWAVES * 64, 2) enc_fwd(Args args) {
    extern __shared__ __attribute__((aligned(16))) unsigned char lds_raw[];
    LAS unsigned char* lds = (LAS unsigned char*)lds_raw;
    volatile LAS unsigned* MISC = (volatile LAS unsigned*)(lds + MISC_OFF);
    const int tid_k = threadIdx.x, wave = __builtin_amdgcn_readfirstlane(tid_k >> 6);
    int tid = tid_k, lane = tid_k & 63;
#define PHASE_IDS() do { int t_ = tid_k; asm volatile("" : "+v"(t_)); tid = t_; lane = t_ & 63; } while (0)
    const int G = gridDim.x, blk = blockIdx.x;
    const int vcu = (G % 8 == 0) ? (blk % 8) * (G / 8) + blk / 8 : blk;
    const int gw = vcu * NWAVES + wave, NGW = G * NWAVES;
    unsigned char* ws = args.ws;
    gu32* ctl = (gu32*)(ws + WS_CTL);
    for (int u = tid_k; u < (LDS_BYTES - LDSCTL_OFF) / 4; u += NWAVES * 64) ((LAS unsigned*)(lds + LDSCTL_OFF))[u] = 0u;
    __syncthreads();
#if MK_SINGLE
    XcdBarrier bar = xcd_barrier_post((unsigned*)(ctl + CW_BAR), MISC + 8);
#define GRID_BAR() xcd_barrier(bar)
#else
#define GRID_BAR() do {} while (0)
#endif
    const int lo = args.ph_lo, hi = args.ph_hi;
#define IN(k) (lo <= (k) && (k) < hi)
#define REP(k) for (int rep_ = 0; rep_ < ((((PROBE_MASK) >> (k)) & 1) ? 2 : 1); ++rep_)
#define SEAM(k) do { if (IN(k) && IN((k) + 1)) GRID_BAR(); } while (0)
    const float* x = args.in[0]; const float* rel_bias = args.in[1]; float* out = args.out;
    bf16* XR = (bf16*)(ws + WS_XR); bf16* WIN0 = (bf16*)(ws + WS_WIN0); bf16* WOUT0 = (bf16*)(ws + WS_WOUT0); bf16* WIN1 = (bf16*)(ws + WS_WIN1); bf16* WOUT1 = (bf16*)(ws + WS_WOUT1);
    unsigned char* WGU0 = ws + WS_WGU0; unsigned char* WDN0 = ws + WS_WDN0; unsigned char* WGU1 = ws + WS_WGU1; unsigned char* WDN1 = ws + WS_WDN1; bf16* XN = (bf16*)(ws + WS_XN); unsigned char* XN8 = ws + WS_XN8;
    float* AFF = (float*)(ws + WS_AFF); int* SEL = (int*)(ws + WS_SEL); int* IDX = (int*)(ws + WS_IDX); float* GATE = (float*)(ws + WS_GATE);
    f32x2* ROPE = (f32x2*)(ws + WS_ROPE);
    bf16* AQ = (bf16*)(ws + WS_AQ); bf16* AK = (bf16*)(ws + WS_AK); bf16* AV = (bf16*)(ws + WS_AV); bf16* BQ = (bf16*)(ws + WS_BQ); bf16* BK = (bf16*)(ws + WS_BK); bf16* BV = (bf16*)(ws + WS_BV);
    bf16* CQ = (bf16*)(ws + WS_CQ); bf16* CK = (bf16*)(ws + WS_CK); bf16* CV = (bf16*)(ws + WS_CV); bf16* OB = (bf16*)(ws + WS_O);
    unsigned char* XS = ws + WS_XS; unsigned char* ACT = ws + WS_ACT; unsigned char* YB = ws + WS_Y;
    LAS float* scr = (LAS float*)(lds + wave * 16640);

    if (IN(0)) REP(0) { PHASE_IDS(); if (rep_) __syncthreads();
        cvt_dense8(args.in[3], DM, L0_IN, (unsigned char*)WIN0, scr, gw, NGW, lane); cvt_dense8(args.in[8], DM, DM, (unsigned char*)WOUT0, scr, gw, NGW, lane);
        cvt_dense8(args.in[15], DM, L1_IN, (unsigned char*)WIN1, scr, gw, NGW, lane); cvt_dense8(args.in[19], DM, DM, (unsigned char*)WOUT1, scr, gw, NGW, lane);
        if (G != 256) { cvt_moe(args.in[11], args.in[12], args.in[13], WGU0, WDN0, scr, gw, NGW, lane); cvt_moe(args.in[22], args.in[23], args.in[24], WGU1, WDN1, scr, gw, NGW, lane); }
        if (blk == 0 && tid < 16) rope_table(ROPE, tid);
        for (int row = 2 * gw; row < NTOK; row += 2 * NGW) rms_row2_to_fp8(x + (size_t)row * DM, args.in[2], (unsigned char*)XN + (size_t)row * DM, lane);
    }
    SEAM(0);
    if (IN(1)) REP(1) { PHASE_IDS(); if (rep_) __syncthreads();
        const int Gg = (G == 256) ? G_P1 : G;
        if (blk < Gg) {
            pg8::Gemm g{XN, WIN0, NTOK, L0_IN, DM / 2}; pg8::StaticOrder S; S.init(NTOK, L0_IN, Gg, blk);
            pg8::EpiHeads0 E{AQ, AK, AV, BQ, BK, BV, args.in[4], args.in[5], args.in[6], args.in[7], (const pg8::f32x2e*)ROPE, QSCALE, QSCALE * KAPPA};
            pg8::gemm_phase<pg8::EpiHeads0, pg8::StaticOrder, PG8_ALIGN, PG8_SP2, true>(lds, g, S, E);
        } else {
            const int ncw = G - Gg, cw = ((ncw % 8) == 0 && (Gg % 8) == 0) ? (blk % 8) * (ncw / 8) + (blk - Gg) / 8 : blk - Gg;
            const int gwl = cw * NWAVES + wave, ngwl = ncw * NWAVES;
            cvt_moe_pipe(args.in[11], args.in[12], args.in[13], WGU0, WDN0, scr, gwl, ngwl, lane, 0, 3 * 8192);
            cvt_moe_pipe(args.in[22], args.in[23], args.in[24], WGU1, WDN1, scr, gwl, ngwl, lane, CVT1_LATE, 3 * 8192);
        }
    }
    SEAM(1);
    if (IN(3)) { PHASE_IDS();
        const attn_body::AttnTensors AT{(const unsigned char*)BQ, (const unsigned char*)BK, (const unsigned char*)BV, (unsigned char*)OB + 512};
        REP(3) attn_body::attn_phase<4>((char*)lds_raw, AT, G, blk);
        REP(21) mixer_a_phase(AQ, AK, AV, OB, (float*)(ws + WS_ST), (float*)(ws + WS_ML), rel_bias, lds, G, blk, tid, lane, wave);
    }
    SEAM(3);
    if (IN(4)) REP(4) { PHASE_IDS(); if (rep_) __syncthreads();
        pg8::Gemm g{OB, WOUT0, NTOK, DM, DM / 2}; pg8::StaticOrder S; S.init(NTOK, DM, G, blk);
        pg8::EpiResid<true> E{x, XR, DM};
        pg8::gemm_phase<pg8::EpiResid<true>, pg8::StaticOrder, PG8_ALIGN, PG8_SP2, true, 0x7a7a7a7au>(lds, g, S, E);
    }
    SEAM(4);
    if (IN(5)) REP(5) { PHASE_IDS(); } if (IN(5)) REP(5) norm_router_phase(XR, args.in[9], args.in[10], XN8, AFF, (LAS float*)lds, gw, NGW, lane, tid);
    SEAM(5);
    if (IN(6)) { PHASE_IDS(); topk_phase(AFF, IDX, GATE, SEL, (LAS unsigned*)lds, G, blk, tid, lane, wave);
        if (G > 64 && blk >= 64) cvt_moe(args.in[22], args.in[23], args.in[24], WGU1, WDN1, scr, (blk - 64) * NWAVES + wave, (G - 64) * NWAVES, lane, 0, CVT1_P6);
        else if (G <= 64) { __syncthreads(); cvt_moe(args.in[22], args.in[23], args.in[24], WGU1, WDN1, scr, gw, NGW, lane, 0, CVT1_P6); } }
    SEAM(6);
    if (IN(8)) REP(8) { PHASE_IDS(); if (rep_) __syncthreads();
        LAS unsigned* rowoff = (LAS unsigned*)(lds + pg8::STAGE_BYTES);
        pg8::MoeGateUpOrder S{G, blk, rowoff};
        { pg8::Unit u_; for (int ui = 0; ui < 16 && S.next(ui, u_); ++ui) if (tid < 256) rowoff[ui * 256 + tid] = (unsigned)((((u_.pm >> 2) & 3) * SEQ + IDX[256 * u_.pm + tid]) * DM); }
        __syncthreads();
        pg8::Gemm g{(const bf16*)XN8, (const bf16*)WGU0, NPAIR, 4096, DM / 2};
        pg8::EpiSwiGLU E{ACT, DFF};
        pg8::gemm_phase<pg8::EpiSwiGLU, pg8::MoeGateUpOrder, PG8_ALIGN, PG8_SP2, true>(lds, g, S, E);
    }
    SEAM(8);
    if (IN(9)) REP(9) { PHASE_IDS(); if (rep_) __syncthreads();
        pg8::Gemm g{(const bf16*)ACT, (const bf16*)WDN0, NPAIR, DM, DFF / 2}; pg8::MoeDownOrder S{G, blk};
        pg8::EpiDown E{YB, GATE, DM};
        pg8::gemm_phase<pg8::EpiDown, pg8::MoeDownOrder, PG8_ALIGN, PG8_SP2, true>(lds, g, S, E);
    }
    SEAM(9);
    if (IN(10)) { PHASE_IDS();
        combine_phase(XR, YB, SEL, args.in[14], XN, nullptr, gw, NGW, lane);
    }
    SEAM(10);
    if (IN(11)) REP(11) { PHASE_IDS(); if (rep_) __syncthreads();
        pg8::Gemm g{XN, WIN1, NTOK, L1_IN, DM / 2}; pg8::StaticOrder S; S.init(NTOK, L1_IN, G, blk);
        pg8::EpiHeads1 E{CQ, CK, CV, args.in[16], args.in[17], QSCALE * KAPPA};
        pg8::gemm_phase<pg8::EpiHeads1, pg8::StaticOrder, PG8_ALIGN, PG8_SP2, true>(lds, g, S, E);
    }
    SEAM(11);
    if (IN(13)) { PHASE_IDS(); mixer_c_shared(CQ, CK, CV, OB, rel_bias, args.in[18], lds, G, blk, tid, lane, wave); }
    SEAM(13);
    if (IN(14)) REP(14) { PHASE_IDS(); if (rep_) __syncthreads();
        pg8::Gemm g{OB, WOUT1, NTOK, DM, DM / 2}; pg8::StaticOrder S; S.init(NTOK, DM, G, blk);
        pg8::EpiResid<false> E{XR, XR, DM};
        pg8::gemm_phase<pg8::EpiResid<false>, pg8::StaticOrder, PG8_ALIGN, PG8_SP2, true, 0x7a7a7a7au>(lds, g, S, E);
    }
    SEAM(14);
    if (IN(15)) REP(15) { PHASE_IDS(); } if (IN(15)) REP(15) norm_router_phase(XR, args.in[20], args.in[21], XN8, AFF, (LAS float*)lds, gw, NGW, lane, tid);
    SEAM(15);
    if (IN(16)) { PHASE_IDS(); topk_phase(AFF, IDX, GATE, SEL, (LAS unsigned*)lds, G, blk, tid, lane, wave);
        if (G > 64 && blk >= 64) cvt_moe(args.in[22], args.in[23], args.in[24], WGU1, WDN1, scr, (blk - 64) * NWAVES + wave, (G - 64) * NWAVES, lane, CVT1_P6, CVT1_LATE);
        else if (G <= 64) { __syncthreads(); cvt_moe(args.in[22], args.in[23], args.in[24], WGU1, WDN1, scr, gw, NGW, lane, CVT1_P6, CVT1_LATE); } }
    SEAM(16);
    if (IN(18)) REP(18) { PHASE_IDS(); if (rep_) __syncthreads();
        LAS unsigned* rowoff = (LAS unsigned*)(lds + pg8::STAGE_BYTES);
        pg8::MoeGateUpOrder S{G, blk, rowoff};
        { pg8::Unit u_; for (int ui = 0; ui < 16 && S.next(ui, u_); ++ui) if (tid < 256) rowoff[ui * 256 + tid] = (unsigned)((((u_.pm >> 2) & 3) * SEQ + IDX[256 * u_.pm + tid]) * DM); }
        __syncthreads();
        pg8::Gemm g{(const bf16*)XN8, (const bf16*)WGU1, NPAIR, 4096, DM / 2};
        pg8::EpiSwiGLU E{ACT, DFF};
        pg8::gemm_phase<pg8::EpiSwiGLU, pg8::MoeGateUpOrder, PG8_ALIGN, PG8_SP2, true>(lds, g, S, E);
    }
    SEAM(18);
    if (IN(19)) REP(19) { PHASE_IDS(); if (rep_) __syncthreads();
        pg8::Gemm g{(const bf16*)ACT, (const bf16*)WDN1, NPAIR, DM, DFF / 2}; pg8::MoeDownOrder S{G, blk};
        pg8::EpiDown E{YB, GATE, DM};
        pg8::gemm_phase<pg8::EpiDown, pg8::MoeDownOrder, PG8_ALIGN, PG8_SP2, true>(lds, g, S, E);
    }
    SEAM(19);
    if (IN(20)) { PHASE_IDS(); } if (IN(20)) combine_phase(XR, YB, SEL, nullptr, nullptr, out, gw, NGW, lane);
#undef IN
#undef SEAM
}

extern "C" void kernel_launch(void* const* d_in, const int* in_sizes, int n_in, void* d_out, int out_size, void* d_ws, size_t ws_size, hipStream_t stream) {
    static int grid = 0;
    if (grid == 0) {
        if (n_in != 25 || in_sizes[0] != NTOK * DM || out_size != NTOK * DM || ws_size < WS_END) { fprintf(stderr, "kernel_launch: unexpected shapes / workspace (n_in %d, ws %zu < %zu); nothing launched\n", n_in, ws_size, (size_t)WS_END); grid = -1; return; }
        int dev = 0, cus = 0, per_cu = 0;
        if (hipGetDevice(&dev) != hipSuccess || hipDeviceGetAttribute(&cus, hipDeviceAttributeMultiprocessorCount, dev) != hipSuccess) { grid = -1; return; }
        if (hipFuncSetAttribute((const void*)enc_fwd, hipFuncAttributeMaxDynamicSharedMemorySize, LDS_BYTES) != hipSuccess) { fprintf(stderr, "kernel_launch: hipFuncSetAttribute failed\n"); grid = -1; return; }
        if (hipOccupancyMaxActiveBlocksPerMultiprocessor(&per_cu, (const void*)enc_fwd, NWAVES * 64, LDS_BYTES) != hipSuccess || per_cu < 1) { fprintf(stderr, "kernel_launch: occupancy query says %d blocks per CU\n", per_cu); }
        (void)hipGetLastError();
        grid = cus;
    }
    if (grid < 0) return;
    (void)hipMemsetAsync((char*)d_ws + WS_CTL, 0, CTL_ZERO_BYTES, stream);
    Args a{};
    for (int i = 0; i < 25; ++i) a.in[i] = (const float*)d_in[i];
    a.out = (float*)d_out; a.ws = (unsigned char*)d_ws;
#if MK_SINGLE
    a.ph_lo = 0; a.ph_hi = N_PHASES;
    hipLaunchKernelGGL(enc_fwd, dim3(grid), dim3(NWAVES * 64), LDS_BYTES, stream, a);
#else
    for (int p = 0; p < N_PHASES; ++p) { a.ph_lo = p; a.ph_hi = p + 1; hipLaunchKernelGGL(enc_fwd, dim3(grid), dim3(NWAVES * 64), LDS_BYTES, stream, a);
#ifdef PROBE_PH
        if (p == PROBE_PH) hipLaunchKernelGGL(enc_fwd, dim3(grid), dim3(NWAVES * 64), LDS_BYTES, stream, a);
#endif
    }
#endif
}
```

```cpp
#include <hip/hip_runtime.h>
#include <hip/hip_bf16.h>
#include <cstdio>
#include <cstdint>
#include <cmath>
#define MK_SINGLE 1
namespace pg8 {
#define PG8_LAS __attribute__((address_space(3)))
typedef unsigned short bf16_t;
typedef short bf16x8 __attribute__((ext_vector_type(8)));
typedef float f32x4 __attribute__((ext_vector_type(4)));
typedef unsigned u32x4 __attribute__((ext_vector_type(4)));
constexpr int BM = 256, BK = 64, HALF = 128, HTB = HALF * BK * 2  , STAGE_BYTES = 8 * HTB, NXCD = 8, WGM = 8;

__host__ __device__ __forceinline__ int lds_byte(int r, int c) { const int st = (r >> 4) * 2 + (c >> 5), rr = r & 15, cc = c & 31, ob = rr * 64 + cc * 2; return st * 1024 + (ob ^ (((ob >> 9) & 1) << 5)); }
__host__ __device__ __forceinline__ void stage_rc(int b, int& R, int& C) { const int st = b / 1024, sb = b % 1024, swz = sb ^ (((sb >> 9) & 1) << 5); R = (st >> 1) * 16 + swz / 64; C = (st & 1) * 32 + (swz % 64) / 2; }
__host__ __device__ __forceinline__ int perm32(int rho) { const int n = rho >> 4, i = rho & 15; return 8 * (i >> 2) + 4 * n + (i & 3); }
__host__ __device__ __forceinline__ int perm16(int rho) { const int n = rho >> 4, i = rho & 15; return 16 * (i >> 2) + 4 * n + (i & 3); }
template <class E, class = void> struct epi_perm16 { static constexpr bool value = false; };
template <class E> struct epi_perm16<E, decltype((void)E::PERM16)> { static constexpr bool value = E::PERM16; };

struct Unit { int pm, pn, pb; };
struct Gemm { const bf16_t* A; const bf16_t* Bt; int M, N, K; };

struct StaticOrder {
    static constexpr bool GATHER = false;
    int nM, nN, nwg, G, c;
    __host__ __device__ void init(int M, int N, int G_, int c_) { nM = M / BM; nN = N / BM; nwg = nM * nN; G = G_; c = c_; }
    __host__ __device__ bool next(int i, Unit& u) const {
        const long L = (long)i * G + c; if (L >= nwg) return false;
        int wgid = (int)L; { const int q = nwg / NXCD, r = nwg % NXCD, xcd = wgid % NXCD, off = wgid / NXCD; wgid = (xcd < r ? xcd * (q + 1) : r * (q + 1) + (xcd - r) * q) + off; }
        const int nig = WGM * nN, gid = wgid / nig, fm = gid * WGM, gsz = (nM - fm) < WGM ? (nM - fm) : WGM;
        u.pm = fm + ((wgid % nig) % gsz); u.pn = (wgid % nig) / gsz; u.pb = u.pn; return true;
    }
    __device__ __forceinline__ void a_ready(const Unit&) const {}
    __device__ __forceinline__ void done(const Unit&) const {}
};

__device__ __forceinline__ unsigned cvt_pk_bf16(float lo, float hi) { unsigned r; asm volatile("v_cvt_pk_bf16_f32 %0, %1, %2" : "=v"(r) : "v"(lo), "v"(hi)); return r; }
typedef float f32x2 __attribute__((ext_vector_type(2)));
template <int ACT  > struct EpiBf16 {
    static constexpr bool PERM = true, AFTER_DRAIN = false, HEADPERM = false; static_assert(ACT == 0, "EpiBf16: ACT is 0 here");
    bf16_t* O; int ldc; const float* bias; int split_cols; size_t split_stride; float scale0;
    __device__ __forceinline__ void operator()(const f32x4 (&acc)[2][2][4][2], const Unit& u, int wr, int wc, int fr, int fq) const {
        const int row0 = u.pm * BM + wr * 64 + fr; int colt = u.pn * BM; bf16_t* base = O;
        float sc = 1.f; if (split_cols) { const int t = colt / split_cols; base += (size_t)t * split_stride; colt -= t * split_cols; if (t == 0) sc = scale0; }
        const int col0 = colt + wc * 32 + 8 * fq, bcol0 = u.pn * BM + wc * 32 + 8 * fq;
        f32x4 bv[2][2];
#pragma unroll
        for (int bj = 0; bj < 2; ++bj)
#pragma unroll
            for (int n = 0; n < 2; ++n) bv[bj][n] = bias ? *(const f32x4*)(bias + bcol0 + bj * HALF + 4 * n) : (f32x4){0.f, 0.f, 0.f, 0.f};
#pragma unroll
        for (int ai = 0; ai < 2; ++ai)
#pragma unroll
            for (int m = 0; m < 4; ++m) { bf16_t* rowp = base + (size_t)(row0 + ai * HALF + m * 16) * ldc + col0;
#pragma unroll
                for (int bj = 0; bj < 2; ++bj) { f32x4 v0 = acc[ai][bj][m][0] + bv[bj][0], v1 = acc[ai][bj][m][1] + bv[bj][1];
                    v0 = v0 * sc; v1 = v1 * sc; u32x4 w; w.x = cvt_pk_bf16(v0[0], v0[1]); w.y = cvt_pk_bf16(v0[2], v0[3]); w.z = cvt_pk_bf16(v1[0], v1[1]); w.w = cvt_pk_bf16(v1[2], v1[3]);
                    *(u32x4*)(rowp + bj * HALF) = w; } }
    }
};
template <unsigned ASC = 0x7f7f7f7fu> __device__ __forceinline__ f32x4 mfma8(bf16x8 w0, bf16x8 w1, bf16x8 x0, bf16x8 x1, f32x4 c) {
    typedef int v4i_ __attribute__((ext_vector_type(4))); typedef int v8i_ __attribute__((ext_vector_type(8)));
    const v4i_ a0 = __builtin_bit_cast(v4i_, w0), a1 = __builtin_bit_cast(v4i_, w1), b0 = __builtin_bit_cast(v4i_, x0), b1 = __builtin_bit_cast(v4i_, x1);
    const v8i_ A = __builtin_shufflevector(a0, a1, 0, 1, 2, 3, 4, 5, 6, 7), B = __builtin_shufflevector(b0, b1, 0, 1, 2, 3, 4, 5, 6, 7);
    asm volatile("v_mfma_scale_f32_16x16x128_f8f6f4 %0, %1, %2, %0, %3, %4 op_sel_hi:[0,0,0]" : "+v"(c) : "v"(A), "v"(B), "v"(0x79797979), "v"(ASC));
    return c;
}
template <class Epi, class Sched, bool ALIGN_EPI = false, bool SP2 = false, bool F8 = false, unsigned ASC = 0x7f7f7f7fu>
__device__ __forceinline__ void gemm_phase(PG8_LAS unsigned char* lds, const Gemm g, const Sched& S, const Epi& E) {
    const int tid = threadIdx.x, wid = __builtin_amdgcn_readfirstlane(tid >> 6), lane = tid & 63, wr = wid >> 2, wc = wid & 3, fr = lane & 15, fq = lane >> 4;
    const int K = g.K, nt = K / BK;
    unsigned voffA[2], voffB[2];
#pragma unroll
    for (int i = 0; i < 2; ++i) { int R, C; stage_rc(tid * 16 + i * 8192, R, C); const int Rb = epi_perm16<Epi>::value ? (64 * (R >> 5) + perm16(R & 31)) : Epi::HEADPERM ? (64 * (R >> 5) + perm32(R & 31)) : (Epi::PERM ? ((R & ~31) + perm32(R & 31)) : R);
        voffA[i] = (unsigned)(R * K + C) * 2u; voffB[i] = (unsigned)(Rb * K + C) * 2u; }
    const size_t kstep = (size_t)(BK * 2);
    const size_t hstep = (size_t)HALF * K * 2;
    const size_t tstep = 2 * hstep;
    const size_t hstepB = epi_perm16<Epi>::value ? (size_t)8 * K * 2 : Epi::HEADPERM ? (size_t)32 * K * 2 : hstep;
    const unsigned ldsw = (unsigned)wid * 1024u;
    const int aoff = lds_byte(wr * 64 + fr, fq * 8), boff = lds_byte(wc * 32 + fr, fq * 8);
#define PG8_SA(b, h) (((b) * 2 + (h)) * HTB)
#define PG8_SB(b, h) ((4 + (b) * 2 + (h)) * HTB)
#define PG8_STAGE(bufoff, gbase, voff) do { _Pragma("unroll") for (int _i = 0; _i < 2; ++_i) \
        __builtin_amdgcn_global_load_lds((const unsigned*)((const char*)(gbase) + (voff)[_i]), (PG8_LAS unsigned*)(lds + (bufoff) + ldsw + _i * 8192), 16, 0, 0); } while (0)
#define PG8_STAGE_A(bufoff, gbase, h, nx) do { if constexpr (Sched::GATHER) { const unsigned vv_[2] = {(nx) ? vAn[h][0] : vA[h][0], (nx) ? vAn[h][1] : vA[h][1]}; PG8_STAGE(bufoff, gbase, vv_); } \
        else { PG8_STAGE(bufoff, (gbase) + (h) * hstep, voffA); } } while (0)
#define PG8_LDA(dst, b, h) do { _Pragma("unroll") for (int m = 0; m < 4; ++m) _Pragma("unroll") for (int k = 0; k < 2; ++k) dst[m][k] = *(const PG8_LAS bf16x8*)(lds + PG8_SA(b, h) + aoff + m * 2048 + k * 1024); } while (0)
#define PG8_LDB(dst, b, h) do { _Pragma("unroll") for (int n = 0; n < 2; ++n) _Pragma("unroll") for (int k = 0; k < 2; ++k) dst[n][k] = *(const PG8_LAS bf16x8*)(lds + PG8_SB(b, h) + boff + n * 2048 + k * 1024); } while (0)
#define PG8_MMA(ai, bj, At, Bt) do { __builtin_amdgcn_s_setprio(1); if constexpr (F8) { asm volatile("s_nop 3"); _Pragma("unroll") for (int m = 0; m < 4; ++m) _Pragma("unroll") for (int n = 0; n < 2; ++n) \
        acc[ai][bj][m][n] = mfma8<ASC>(Bt[n][0], Bt[n][1], At[m][0], At[m][1], acc[ai][bj][m][n]); } else { _Pragma("unroll") for (int m = 0; m < 4; ++m) _Pragma("unroll") for (int n = 0; n < 2; ++n) _Pragma("unroll") for (int k = 0; k < 2; ++k) \
        acc[ai][bj][m][n] = __builtin_amdgcn_mfma_f32_16x16x32_bf16(Bt[n][k], At[m][k], acc[ai][bj][m][n], 0, 0, 0); } __builtin_amdgcn_s_setprio(0); } while (0)
#define PG8_WAIT_V(n) asm volatile("s_waitcnt vmcnt(" #n ")" ::: "memory")
#define PG8_WAIT_L(n) asm volatile("s_waitcnt lgkmcnt(" #n ")" ::: "memory")
#define PG8_BAR __builtin_amdgcn_s_barrier()
#define PG8_SCHED __builtin_amdgcn_sched_barrier(0)
    Unit cur, nxt; int ui = 0;
    if (!S.next(0, cur)) return;
    f32x4 acc[2][2][4][2];
#pragma unroll
    for (int a = 0; a < 2; ++a)
#pragma unroll
        for (int b = 0; b < 2; ++b)
#pragma unroll
            for (int m = 0; m < 4; ++m)
#pragma unroll
                for (int n = 0; n < 2; ++n) acc[a][b][m][n] = (f32x4){0.f, 0.f, 0.f, 0.f};
    bf16x8 At[4][2], B0[2][2], B1[2][2];
    const char* cA = Sched::GATHER ? (const char*)g.A : (const char*)g.A + (size_t)cur.pm * tstep; const char* cB = (const char*)g.Bt + (size_t)cur.pb * tstep;
    unsigned vA[2][2] = {{0u, 0u}, {0u, 0u}}, vAn[2][2] = {{0u, 0u}, {0u, 0u}};
    static_assert(SP2 || !Sched::GATHER, "GATHER is wired into the SP2 loop only");
#define PG8_AOFF(dst, ui_) do { if constexpr (Sched::GATHER) { _Pragma("unroll") for (int h_ = 0; h_ < 2; ++h_) _Pragma("unroll") for (int i_ = 0; i_ < 2; ++i_) { int R_, C_; stage_rc(tid * 16 + i_ * 8192, R_, C_); \
        dst[h_][i_] = S.a_off(ui_, h_ * HALF + R_) + (unsigned)C_ * 2u; } } } while (0)
    PG8_AOFF(vA, 0);
    S.a_ready(cur);
    if constexpr (SP2) {
        PG8_STAGE(PG8_SB(0, 0), cB, voffB); PG8_STAGE(PG8_SB(0, 1), cB + hstepB, voffB); PG8_STAGE_A(PG8_SA(0, 0), cA, 0, false); PG8_STAGE_A(PG8_SA(0, 1), cA, 1, false);
        if (wr == 1) PG8_BAR;
        PG8_WAIT_V(2); PG8_BAR;
        PG8_STAGE(PG8_SB(1, 0), cB + kstep, voffB); PG8_STAGE_A(PG8_SA(1, 0), cA + kstep, 0, false); PG8_STAGE(PG8_SB(1, 1), cB + hstepB + kstep, voffB);
        PG8_WAIT_V(6); PG8_BAR;
    } else {
        PG8_STAGE(PG8_SB(0, 0), cB, voffB); PG8_STAGE(PG8_SA(0, 0), cA, voffA); PG8_STAGE(PG8_SB(0, 1), cB + hstepB, voffB); PG8_STAGE(PG8_SA(0, 1), cA + hstep, voffA);
        if (wr == 1) PG8_BAR;
        PG8_WAIT_V(4); PG8_BAR;
        PG8_STAGE(PG8_SB(1, 0), cB + kstep, voffB); PG8_STAGE(PG8_SA(1, 0), cA + kstep, voffA); PG8_STAGE(PG8_SB(1, 1), cB + hstepB + kstep, voffB);
        PG8_WAIT_V(6); PG8_BAR;
    }
    for (;;) {
        const bool has_next = S.next(ui + 1, nxt);
        const char* nA = Sched::GATHER ? cA : (has_next ? (const char*)g.A + (size_t)nxt.pm * tstep : cA);
        if constexpr (Sched::GATHER) { if (has_next) { PG8_AOFF(vAn, ui + 1); } else { _Pragma("unroll") for (int h_ = 0; h_ < 2; ++h_) _Pragma("unroll") for (int i_ = 0; i_ < 2; ++i_) vAn[h_][i_] = vA[h_][i_]; } } const char* nB = has_next ? (const char*)g.Bt + (size_t)nxt.pb * tstep : cB;
#pragma nounroll
        for (int t = 0; t < nt; t += 2) {
            const bool last = (t == nt - 2);
            const char* a1 = cA + (size_t)(t + 1) * kstep;
            const char* a2 = last ? nA : cA + (size_t)(t + 2) * kstep; const char* b2 = last ? nB : cB + (size_t)(t + 2) * kstep;
            const char* a3 = a2 + kstep; const char* b3 = b2 + kstep;
            if (last && has_next) S.a_ready(nxt);
            if constexpr (SP2) {
            PG8_LDB(B0, 0, 0); PG8_LDB(B1, 0, 1); PG8_SCHED; PG8_LDA(At, 0, 0); PG8_STAGE_A(PG8_SA(1, 1), a1, 1, false);
            PG8_WAIT_V(8); PG8_WAIT_L(0); PG8_BAR; PG8_MMA(0, 0, At, B0); PG8_MMA(0, 1, At, B1); PG8_BAR; PG8_SCHED;
            PG8_LDA(At, 0, 1); PG8_STAGE(PG8_SB(0, 0), b2, voffB); PG8_STAGE(PG8_SB(0, 1), b2 + hstepB, voffB); PG8_STAGE_A(PG8_SA(0, 0), a2, 0, last);
            PG8_WAIT_V(8); PG8_WAIT_L(0); PG8_BAR; PG8_MMA(1, 0, At, B0); PG8_MMA(1, 1, At, B1); PG8_BAR; PG8_SCHED;
            PG8_LDB(B0, 1, 0); PG8_LDB(B1, 1, 1); PG8_SCHED; PG8_LDA(At, 1, 0); PG8_STAGE_A(PG8_SA(0, 1), a2, 1, last);
            PG8_WAIT_V(8); PG8_WAIT_L(0); PG8_BAR; PG8_MMA(0, 0, At, B0); PG8_MMA(0, 1, At, B1); PG8_BAR; PG8_SCHED;
            PG8_LDA(At, 1, 1); PG8_STAGE(PG8_SB(1, 0), b3, voffB); PG8_STAGE(PG8_SB(1, 1), b3 + hstepB, voffB); PG8_STAGE_A(PG8_SA(1, 0), a3, 0, last);
            PG8_WAIT_V(8); PG8_WAIT_L(0); PG8_BAR; PG8_MMA(1, 0, At, B0); PG8_MMA(1, 1, At, B1); PG8_BAR; PG8_SCHED;
            } else {
            PG8_LDB(B0, 0, 0); PG8_SCHED; PG8_LDA(At, 0, 0); PG8_STAGE(PG8_SA(1, 1), a1 + hstep, voffA);
            PG8_WAIT_L(8); PG8_BAR; PG8_WAIT_L(0); PG8_MMA(0, 0, At, B0); PG8_BAR; PG8_SCHED;
            PG8_LDB(B1, 0, 1); PG8_STAGE(PG8_SB(0, 0), b2, voffB);
            PG8_BAR; PG8_WAIT_L(0); PG8_MMA(0, 1, At, B1); PG8_BAR;
            PG8_LDA(At, 0, 1); PG8_STAGE(PG8_SA(0, 0), a2, voffA);
            PG8_BAR; PG8_WAIT_L(0); PG8_MMA(1, 0, At, B0); PG8_BAR; PG8_SCHED;
            PG8_STAGE(PG8_SB(0, 1), b2 + hstepB, voffB);
            PG8_WAIT_V(6); PG8_BAR; PG8_MMA(1, 1, At, B1); PG8_BAR;
            PG8_LDB(B0, 1, 0); PG8_SCHED; PG8_LDA(At, 1, 0); PG8_STAGE(PG8_SA(0, 1), a2 + hstep, voffA);
            PG8_WAIT_L(8); PG8_BAR; PG8_WAIT_L(0); PG8_MMA(0, 0, At, B0); PG8_BAR; PG8_SCHED;
            PG8_LDB(B1, 1, 1); PG8_STAGE(PG8_SB(1, 0), b3, voffB);
            PG8_BAR; PG8_WAIT_L(0); PG8_MMA(0, 1, At, B1); PG8_BAR;
            PG8_LDA(At, 1, 1); PG8_STAGE(PG8_SA(1, 0), a3, voffA);
            PG8_BAR; PG8_WAIT_L(0); PG8_MMA(1, 0, At, B0); PG8_BAR; PG8_SCHED;
            PG8_STAGE(PG8_SB(1, 1), b3 + hstepB, voffB);
            PG8_WAIT_V(6); PG8_BAR; PG8_MMA(1, 1, At, B1); PG8_BAR;
            }
        }
        if constexpr (F8) asm volatile("s_nop 15\n\ts_nop 15\n\ts_nop 15" ::: "memory");
        if constexpr (ALIGN_EPI) { if (wr == 0) PG8_BAR; }
        if constexpr (!Epi::AFTER_DRAIN) { E(acc, cur, wr, wc, fr, fq); S.done(cur); }
        if (!has_next) break;
#pragma unroll
        for (int a = 0; a < 2; ++a)
#pragma unroll
            for (int b = 0; b < 2; ++b)
#pragma unroll
                for (int m = 0; m < 4; ++m)
#pragma unroll
                    for (int n = 0; n < 2; ++n) acc[a][b][m][n] = (f32x4){0.f, 0.f, 0.f, 0.f};
        cur = nxt; cA = nA; cB = nB; ++ui;
        if constexpr (Sched::GATHER) { _Pragma("unroll") for (int h_ = 0; h_ < 2; ++h_) _Pragma("unroll") for (int i_ = 0; i_ < 2; ++i_) vA[h_][i_] = vAn[h_][i_]; }
        if constexpr (ALIGN_EPI) { if (wr == 1) PG8_BAR; }
    }
    PG8_WAIT_V(0);
    if constexpr (!ALIGN_EPI) { if (wr == 0) PG8_BAR; }
    PG8_BAR;
    if constexpr (Epi::AFTER_DRAIN) { E.fused(acc, cur, wr, wc, fr, fq, lds, wid, lane); S.done(cur); }
#undef PG8_SA
#undef PG8_SB
#undef PG8_STAGE
#undef PG8_LDA
#undef PG8_STAGE_A
#undef PG8_AOFF
#undef PG8_LDB
#undef PG8_MMA
#undef PG8_WAIT_V
#undef PG8_WAIT_L
#undef PG8_BAR
#undef PG8_SCHED
}
}

namespace attn_body {
using bf16=__hip_bfloat16;
using bf16x8=__attribute__((ext_vector_type(8)))short;
using s16x4=__attribute__((ext_vector_type(4)))short;
using f32x16=__attribute__((ext_vector_type(16)))float;
using f32x4=__attribute__((ext_vector_type(4)))float;
using u32x4=__attribute__((ext_vector_type(4)))unsigned;
constexpr int SEQ=8192,D=64;
constexpr int NW=8,QBLK=32,QB=QBLK*NW,KVBLK=64,NQB=SEQ/QB;
constexpr int QP8=512,KP8=128,VTP=SEQ,OP=1024, ATTN_UNIT_ROWS=QB; constexpr float OSCALE=32.f;
__host__ __device__ __forceinline__ int vt_pos(int k){ const int half=k>>5,k5=k&31; return 32*((k5>>2)&1)+16*half+(k5&3)+4*(k5>>3); }
typedef int v8i_t __attribute__((ext_vector_type(8))); typedef int v4i_t __attribute__((ext_vector_type(4)));
__device__ __forceinline__ f32x16 qk8(bf16x8 klo,bf16x8 khi,v8i_t q,f32x16 c){ const v4i_t a0=__builtin_bit_cast(v4i_t,klo),a1=__builtin_bit_cast(v4i_t,khi);
  const v8i_t A=__builtin_shufflevector(a0,a1,0,1,2,3,4,5,6,7); return __builtin_amdgcn_mfma_scale_f32_32x32x64_f8f6f4(A,q,c,0,0,0,0x7f7f7f7f,0,0x75757575); }
__device__ __forceinline__ f32x16 pv8(v8i_t p,bf16x8 vlo,bf16x8 vhi,f32x16 c){ const v4i_t b0=__builtin_bit_cast(v4i_t,vlo),b1=__builtin_bit_cast(v4i_t,vhi);
  const v8i_t B=__builtin_shufflevector(b0,b1,0,1,2,3,4,5,6,7); return __builtin_amdgcn_mfma_scale_f32_32x32x64_f8f6f4(p,B,c,1,0,0,0x7f7f7f7f,0,0x7f7f7f7f); }
__device__ __forceinline__ unsigned pk4f8(float a,float b,float c,float d){ unsigned w=0u; w=__builtin_amdgcn_cvt_pk_fp8_f32(a,b,w,false); w=__builtin_amdgcn_cvt_pk_fp8_f32(c,d,w,true); return w; }
__device__ __forceinline__ unsigned pk4u8(float a,float b,float c,float d){ unsigned w=__builtin_amdgcn_cvt_pk_u8_f32(a,0u,0u); w=__builtin_amdgcn_cvt_pk_u8_f32(b,1u,w); w=__builtin_amdgcn_cvt_pk_u8_f32(c,2u,w); return __builtin_amdgcn_cvt_pk_u8_f32(d,3u,w); }
__device__ __forceinline__ int crow(int r,int hi){return (r&3)+8*(r>>2)+4*hi;}
#define SBAR() __builtin_amdgcn_sched_barrier(0)
constexpr int NSLOT=4, SLOTB=4096;
constexpr int LDS_K=0, LDS_V=NSLOT*SLOTB, LDS_WS=2*NSLOT*SLOTB, LDS_OST=LDS_WS+NW*64*4, LDS_FLAG=LDS_OST+NW*4096, LDS_BYTES=LDS_FLAG+64;
constexpr float C2=0.125f*1.4426950408889634f;
__device__ __forceinline__ void glds16(const void*gsrc,unsigned lds_dst){unsigned keep;
  asm volatile("s_mov_b32 %0, m0\n\ts_mov_b32 m0, %2\n\ts_nop 0\n\tglobal_load_lds_dwordx4 %1, off\n\ts_mov_b32 m0, %0":"=&s"(keep):"v"(gsrc),"s"(lds_dst):"memory");}
__device__ __forceinline__ void glds16h(const void*gsrc,unsigned lds_dst){unsigned keep;
  asm volatile("s_mov_b32 %0, m0\n\ts_mov_b32 m0, %2\n\ts_mov_b32 exec_hi, 0\n\tglobal_load_lds_dwordx4 %1, off\n\ts_mov_b32 exec_hi, -1\n\ts_mov_b32 m0, %0":"=&s"(keep):"v"(gsrc),"s"(lds_dst):"memory");}
__device__ __forceinline__ void glds16hs(const void*sbase,unsigned voff,unsigned lds_dst){unsigned keep;
  asm volatile("s_mov_b32 %0, m0\n\ts_mov_b32 m0, %3\n\ts_mov_b32 exec_hi, 0\n\tglobal_load_lds_dwordx4 %1, %2\n\ts_mov_b32 exec_hi, -1\n\ts_mov_b32 m0, %0":"=&s"(keep):"v"(voff),"s"(sbase),"s"(lds_dst):"memory");}
__device__ __forceinline__ float max3f(float a,float b,float c){float r;asm("v_max3_f32 %0, %1, %2, %3":"=v"(r):"v"(a),"v"(b),"v"(c));return r;}
__device__ __forceinline__ float max2f(float a,float b){float r;asm("v_max_f32_e32 %0, %1, %2":"=v"(r):"v"(a),"v"(b));return r;}
__device__ __forceinline__ float fadd_s(float a,float b){float r;asm("v_add_f32_e32 %0, %1, %2":"=v"(r):"v"(a),"v"(b));return r;}
__device__ __forceinline__ float fsub_s(float a,float b){float r;asm("v_sub_f32_e32 %0, %1, %2":"=v"(r):"v"(a),"v"(b));return r;}
typedef float f32x2_t __attribute__((ext_vector_type(2))); typedef __bf16 bf16x2_t __attribute__((ext_vector_type(2)));
__device__ __forceinline__ unsigned cvtpk_s(float lo,float hi){f32x2_t v={lo,hi};bf16x2_t b=__builtin_convertvector(v,bf16x2_t);return __builtin_bit_cast(unsigned,b);}
#define WAIT_BAR(N) asm volatile("s_waitcnt vmcnt(" #N ") lgkmcnt(0)\n\ts_barrier":::"memory")

__device__ __forceinline__ void qkt(f32x16&p0,f32x16&p1,const char*Kslot,v8i_t q8,const f32x16&negm,int r32,int hi){
  const char*kb=Kslot+hi*2048+r32*16;
  const bf16x8 a0=*reinterpret_cast<const bf16x8*>(kb),a1=*reinterpret_cast<const bf16x8*>(kb+1024),b0=*reinterpret_cast<const bf16x8*>(kb+512),b1=*reinterpret_cast<const bf16x8*>(kb+1536);
  p0=qk8(a0,a1,q8,negm); p1=qk8(b0,b1,q8,negm);
}
typedef __attribute__((address_space(3))) const char* lds_cptr;
typedef short v4i16_t __attribute__((ext_vector_type(4)));
__device__ __forceinline__ void kload1(bf16x8*kf,lds_cptr kp,int j){ kf[j]=*(const __attribute__((address_space(3))) bf16x8*)(kp+(j>>1)*512+(j&1)*1024); }
__device__ __forceinline__ void kload4(bf16x8*kf,lds_cptr kp){ kload1(kf,kp,0); kload1(kf,kp,1); kload1(kf,kp,2); kload1(kf,kp,3); }
__device__ __forceinline__ s16x4 vtr(lds_cptr p){ return __builtin_bit_cast(s16x4,__builtin_amdgcn_ds_read_tr16_b64_v4i16((__attribute__((address_space(3))) v4i16_t*)p)); }
__device__ __forceinline__ float rowmax(const f32x16&p0,const f32x16&p1){
  float a=max3f(p0[0],p0[1],p1[0]),b=max3f(p0[2],p0[3],p1[1]);a=max3f(a,p1[2],p1[3]);
  #pragma unroll
  for(int r=4;r<16;r+=4){a=max3f(a,p0[r],p0[r+1]);b=max3f(b,p0[r+2],p0[r+3]);a=max3f(a,p1[r],p1[r+1]);b=max3f(b,p1[r+2],p1[r+3]);}
  const float m=max2f(a,b);
  auto rr=__builtin_amdgcn_permlane32_swap(__float_as_uint(m),__float_as_uint(m),false,false);
  return max2f(__uint_as_float(rr[0]),__uint_as_float(rr[1]));
}
#ifndef ATTN_STORE16
#define ATTN_STORE16(p,v) (*(u32x4*)(p)=(v))
#endif
template<int THRL> __device__ __forceinline__ void attn_unit(int b,int qb,const unsigned char*Q,const unsigned char*__restrict__ K,const unsigned char*__restrict__ VT,unsigned char*O,char*shm){
  const int tid=threadIdx.x,lane=tid&63,r32=lane&31,hi=lane>>5; const int wid=__builtin_amdgcn_readfirstlane(tid>>6);
  const long rowbase=(long)b*SEQ; const int q0=qb*QB;
  const unsigned char*Qw=Q+(rowbase+q0+wid*QBLK)*QP8;
  const unsigned char*Kh=K+rowbase*KP8;
  const unsigned lds0=(unsigned)(uintptr_t)shm;
  float*wsf=(float*)(shm+LDS_WS)+wid*64;
  const unsigned char*ksrc=Kh+(long)(32*(wid&1))*KP8+(wid>>1)*16; const unsigned klo=(unsigned)(lane&31)*KP8;
  const unsigned char*vsrc=VT+(long)(32*(wid&1))*VTP+(wid>>1)*16; const unsigned vlo=(unsigned)(lane&31)*VTP;
  const unsigned kdst=lds0+LDS_K+(wid>>1)*1024+(wid&1)*512, vdst=lds0+LDS_V+(wid>>1)*1024+(wid&1)*512;
  #define DMA_K(t,slot) glds16hs(ksrc+(long)(t)*KVBLK*KP8,klo,(unsigned)__builtin_amdgcn_readfirstlane(kdst+(slot)))
  #define DMA_V(t,slot) glds16hs(vsrc+(long)(t)*KVBLK,vlo,(unsigned)__builtin_amdgcn_readfirstlane(vdst+(slot)))
  const char*Kbase=shm+LDS_K; bf16x8 kf[4];
  const lds_cptr shm3=(lds_cptr)shm; const lds_cptr kp0=shm3+LDS_K+hi*2048+r32*16; const lds_cptr vp0=shm3+LDS_V+hi*2048+r32*16;
  constexpr int NT=SEQ/KVBLK;
  v8i_t q8; { const v4i_t qa=*reinterpret_cast<const v4i_t*>(Qw+(long)r32*QP8+32*hi), qb_=*reinterpret_cast<const v4i_t*>(Qw+(long)r32*QP8+32*hi+16); q8=__builtin_shufflevector(qa,qb_,0,1,2,3,4,5,6,7); }
  const int one4_=((lane&15)==((lane>>4)&1))?0x38383838:0; const v8i_t vones={one4_,one4_,one4_,one4_,one4_,one4_,one4_,one4_};
  constexpr float ZS=1.f/256.f, RBZ=32.5f*ZS;
  f32x16 o[2]; f32x4 o2; float refz=0.f;
  #define PKN(X,B) __builtin_bit_cast(unsigned,__builtin_amdgcn_cvt_pknorm_u16(X[B],X[(B)+1]))
  #define PRM(w1,w0) __builtin_amdgcn_perm((w1),(w0),0x07050301u)
  #define PACK16(PC,J,X,orv) do{ const unsigned w0_=PKN(X,0),w1_=PKN(X,2),w2_=PKN(X,4),w3_=PKN(X,6),w4_=PKN(X,8),w5_=PKN(X,10),w6_=PKN(X,12),w7_=PKN(X,14); \
      PC[(J)]=(int)PRM(w1_,w0_); PC[(J)+1]=(int)PRM(w3_,w2_); PC[(J)+2]=(int)PRM(w5_,w4_); PC[(J)+3]=(int)PRM(w7_,w6_); \
      asm("v_or3_b32 %0, %0, %1, %2":"+v"(orv):"v"(PC[(J)]),"v"(PC[(J)+1])); asm("v_or3_b32 %0, %0, %1, %2":"+v"(orv):"v"(PC[(J)+2]),"v"(PC[(J)+3])); }while(0)
  #define PIN(x) asm volatile("; pin " #x :"+v"(x))
  #define VRD(i) do{ vf[i]=*(const __attribute__((address_space(3))) bf16x8*)(vp_+((i)>>1)*512+((i)&1)*1024); }while(0)
  #define KRD(G,j) do{ if(G){ kload1(kf,kp0+sl_next,j); } }while(0)
  #define ROT() do{sl_prev=sl_cur;sl_cur=sl_next;sl_next=sl_nx2;sl_nx2=(sl_nx2==(NSLOT-1)*SLOTB)?0:sl_nx2+SLOTB;}while(0)
  #define STEP(PC,PP,t,GK,GV,GL) do{ SBAR(); \
    const lds_cptr vp_=vp0+sl_prev; \
    VRD(0); VRD(1); VRD(2); VRD(3); \
    C0=qk8(kf[0],kf[1],q8,negm); \
    C1=qk8(kf[2],kf[3],q8,negm); SBAR(); \
    if(GK){DMA_K((t)+4,sl_cur);} if(GV){DMA_V((t)+2,sl_nx2);} SBAR(); \
    o[0]=pv8(PP,vf[0],vf[1],o[0]); KRD(GL,0); KRD(GL,1); \
    PACK16(PC,0,C0,orv); PIN(PC); PIN(o[0]); SBAR(); \
    o[1]=pv8(PP,vf[2],vf[3],o[1]); KRD(GL,2); KRD(GL,3); \
    PACK16(PC,4,C1,orv); PIN(PC); PIN(o[1]); SBAR(); \
    o2=__builtin_amdgcn_mfma_scale_f32_16x16x128_f8f6f4(PP,vones,o2,1,0,0,0x7f7f7f7f,0,0x7f7f7f7f); PIN(o2); SBAR(); \
    }while(0)
  #define ENDW(tt) do{ if((tt)+4<NT){WAIT_BAR(4);} else if((tt)+3<NT){WAIT_BAR(3);} else if((tt)+2<NT){WAIT_BAR(2);} else {WAIT_BAR(0);} }while(0)
  unsigned*vflag=(unsigned*)(shm+LDS_FLAG);
  #pragma nounroll
  for(int attempt=0;;++attempt){
    f32x16 negm=f32x16{};asm volatile("":"+v"(negm));
    f32x16 C0,C1; v8i_t p8A,p8B; bf16x8 vf[4]; unsigned orv=0u;
    o[0]=f32x16{};o[1]=f32x16{};o2=f32x4{};
    int sl_prev=0,sl_cur=0,sl_next=SLOTB,sl_nx2=2*SLOTB;
    DMA_K(0,0);DMA_V(0,0);DMA_K(1,SLOTB);DMA_V(1,SLOTB);DMA_K(2,2*SLOTB);DMA_K(3,3*SLOTB);
    WAIT_BAR(5);
    qkt(C0,C1,Kbase,q8,negm,r32,hi);asm volatile("s_nop 15\n\ts_nop 15\n\ts_nop 7":"+v"(C0),"+v"(C1));
    { const float rm=(attempt==0)?rowmax(C0,C1):refz; const float cy=RBZ-rm;
      _Pragma("unroll") for(int r=0;r<16;++r){C0[r]=fadd_s(C0[r],cy);C1[r]=fadd_s(C1[r],cy);}
      _Pragma("unroll") for(int r=0;r<16;++r)negm[r]=cy; asm volatile("":"+v"(negm));
      PACK16(p8A,0,C0,orv); PACK16(p8A,4,C1,orv); }
    WAIT_BAR(3);
    DMA_K(4,0);DMA_V(2,2*SLOTB);
    ROT();
    kload4(kf,kp0+sl_cur);
    WAIT_BAR(3);
    int t=1;
    for(;t+5<NT;t+=2){
      STEP(p8B,p8A,t,true,true,true);     WAIT_BAR(4); ROT();
      STEP(p8A,p8B,t+1,true,true,true);   WAIT_BAR(4); ROT();
    }
    for(;t+1<NT;t+=2){
      STEP(p8B,p8A,t,(t+4<NT),(t+2<NT),(t+1<NT));       ENDW(t);   ROT();
      STEP(p8A,p8B,t+1,(t+5<NT),(t+3<NT),(t+2<NT));     ENDW(t+1); ROT();
    }
    STEP(p8B,p8A,NT-1,false,false,false);
    { const lds_cptr vp_=vp0+sl_cur; VRD(0); VRD(1); VRD(2); VRD(3); SBAR();
      o[0]=pv8(p8B,vf[0],vf[1],o[0]); o[1]=pv8(p8B,vf[2],vf[3],o[1]); o2=__builtin_amdgcn_mfma_scale_f32_16x16x128_f8f6f4(p8B,vones,o2,1,0,0,0x7f7f7f7f,0,0x7f7f7f7f); }
    bool bad=__any((orv&0xC0C0C0C0u)!=0u);
#if defined(PROBE_VAR) && PROBE_VAR==9
    bad=true;
#endif
    if(lane==0)vflag[wid]=(bad&&attempt==0)?1u:0u;
    asm volatile("s_waitcnt lgkmcnt(0)\n\ts_barrier":::"memory");
    const bool redo=__any(vflag[lane&7]!=0u);
    if(__builtin_expect(!redo,1))break;
    { f32x16 z0=f32x16{}; asm volatile("":"+v"(z0)); float rmx=-3.0e38f;
      for(int tt=0;tt<NT;++tt){
        asm volatile("s_barrier":::"memory");
        DMA_K(tt,0); WAIT_BAR(0);
        f32x16 m0,m1; qkt(m0,m1,Kbase,q8,z0,r32,hi); asm volatile("s_nop 15\n\ts_nop 15\n\ts_nop 7":"+v"(m0),"+v"(m1));
        rmx=max2f(rmx,rowmax(m0,m1)); }
      refz=rmx;
      asm volatile("s_waitcnt lgkmcnt(0)\n\ts_barrier":::"memory"); }
  }
  #undef PKN
  #undef PRM
  #undef PACK16
  #undef PIN
  #undef VRD
  #undef KRD
  #undef STEP
  #undef ENDW
  #undef ROT
  if((lane&15)<2){
    #pragma unroll
    for(int i=0;i<4;++i)wsf[32+16*(lane&15)+4*(lane>>4)+i]=o2[i]; }
  asm volatile("s_waitcnt lgkmcnt(0)":::"memory");
  float rli[16];
  #pragma unroll
  for(int r=0;r<16;++r)rli[r]=__builtin_amdgcn_rcpf(wsf[32+crow(r,hi)]);
  unsigned char*Ow=O+(rowbase+q0+wid*QBLK)*OP;
  { unsigned char*stg=(unsigned char*)(shm+LDS_OST)+wid*2048;
    #pragma unroll
    for(int r=0;r<16;++r){const int orow=crow(r,hi); const float s_=rli[r]*OSCALE;
      const unsigned w=(unsigned)__builtin_amdgcn_cvt_pk_fp8_f32(o[0][r]*s_,o[1][r]*s_,0,false);
      stg[orow*64+r32]=(unsigned char)(w&0xffu); stg[orow*64+32+r32]=(unsigned char)((w>>8)&0xffu);}
    asm volatile("s_waitcnt lgkmcnt(0)":::"memory");
    #pragma unroll
    for(int i=0;i<2;++i){const int row=i*16+(lane>>2),ch=lane&3; const u32x4 v=*(const u32x4*)(stg+row*64+ch*16); ATTN_STORE16(Ow+(long)row*OP+ch*16,v);} }
  asm volatile("s_waitcnt lgkmcnt(0)\n\ts_barrier":::"memory");
  #undef DMA_K
  #undef DMA_V
}
constexpr int ATTN_LDS_BYTES=LDS_BYTES;
struct AttnTensors { const unsigned char* Q; const unsigned char* K; const unsigned char* VT; unsigned char* O; };
template<int THRL=8> __device__ __forceinline__ void attn_phase(char*lds,const AttnTensors&T,int grid,int block){
  const int nx=(grid%8==0)?8:1, x=block%nx, slot=block/nx, per=grid/nx;
  for(int s8=x;s8<8;s8+=nx){ const int b=s8>>1,kvh=s8&1;
    for(int u=slot;u<128;u+=per){ const int h=4*kvh+(u>>5),qb=u&31;
      attn_unit<THRL>(b,qb,T.Q+h*D,T.K+kvh*D,T.VT+(long)(b*2+kvh)*D*SEQ,T.O+h*D,lds); } }
}
#undef SBAR
#undef WAIT_BAR
}


namespace pg8 {
template <bool RESID_F32> struct EpiResid {
    static constexpr bool PERM = true, AFTER_DRAIN = false, HEADPERM = false, PERM16 = true;
    const void* resid; bf16_t* out; int ldc;
    __device__ __forceinline__ void operator()(const f32x4 (&acc)[2][2][4][2], const Unit& u, int wr, int wc, int fr, int fq) const {
        const int row0 = u.pm * BM + wr * 64 + fr, col0 = u.pn * BM + wc * 64 + 16 * fq;
#pragma unroll
        for (int ai = 0; ai < 2; ++ai)
#pragma unroll
            for (int m = 0; m < 4; ++m) { const size_t off = (size_t)(row0 + ai * HALF + m * 16) * ldc + col0;
                f32x4 r[4];
                if constexpr (RESID_F32) {
#pragma unroll
                    for (int p = 0; p < 4; ++p) r[p] = *(const f32x4*)((const float*)resid + off + 4 * p); }
                else { const u32x4 w0 = *(const u32x4*)((const bf16_t*)resid + off), w1 = *(const u32x4*)((const bf16_t*)resid + off + 8);
                    r[0] = (f32x4){__uint_as_float(w0.x << 16), __uint_as_float(w0.x & 0xffff0000u), __uint_as_float(w0.y << 16), __uint_as_float(w0.y & 0xffff0000u)};
                    r[1] = (f32x4){__uint_as_float(w0.z << 16), __uint_as_float(w0.z & 0xffff0000u), __uint_as_float(w0.w << 16), __uint_as_float(w0.w & 0xffff0000u)};
                    r[2] = (f32x4){__uint_as_float(w1.x << 16), __uint_as_float(w1.x & 0xffff0000u), __uint_as_float(w1.y << 16), __uint_as_float(w1.y & 0xffff0000u)};
                    r[3] = (f32x4){__uint_as_float(w1.z << 16), __uint_as_float(w1.z & 0xffff0000u), __uint_as_float(w1.w << 16), __uint_as_float(w1.w & 0xffff0000u)}; }
                unsigned o[8];
#pragma unroll
                for (int bj = 0; bj < 2; ++bj)
#pragma unroll
                    for (int n = 0; n < 2; ++n) { const f32x4 v = r[2 * bj + n] + acc[ai][bj][m][n]; o[4 * bj + 2 * n] = cvt_pk_bf16(v[0], v[1]); o[4 * bj + 2 * n + 1] = cvt_pk_bf16(v[2], v[3]); }
                *(u32x4*)(out + off) = (u32x4){o[0], o[1], o[2], o[3]}; *(u32x4*)(out + off + 8) = (u32x4){o[4], o[5], o[6], o[7]}; }
    }
};
__device__ __forceinline__ float silu_mul(float g, float u) { const float e = __builtin_amdgcn_exp2f(-g); return (g * u) * __builtin_amdgcn_rcpf(1.0f + e); }
__device__ __forceinline__ unsigned pk4_fp8(float a, float b, float c, float d) { unsigned w = 0u; w = __builtin_amdgcn_cvt_pk_fp8_f32(a, b, w, false); w = __builtin_amdgcn_cvt_pk_fp8_f32(c, d, w, true); return w; }
__device__ __forceinline__ float clamp448(float v) { return __builtin_amdgcn_fmed3f(v, -448.f, 448.f); }
struct EpiSwiGLU {
    static constexpr bool PERM = true, AFTER_DRAIN = false, HEADPERM = false;
    unsigned char* O; int ldc;
    __device__ __forceinline__ void operator()(const f32x4 (&acc)[2][2][4][2], const Unit& u, int wr, int wc, int fr, int fq) const {
        const int row0 = u.pm * BM + wr * 64 + fr, col0 = u.pn * HALF + wc * 32 + 8 * fq;
#pragma unroll
        for (int ai = 0; ai < 2; ++ai)
#pragma unroll
            for (int m = 0; m < 4; ++m) { unsigned char* rowp = O + (size_t)(row0 + ai * HALF + m * 16) * ldc + col0;
                const f32x4 g0 = acc[ai][0][m][0], g1 = acc[ai][0][m][1], u0 = acc[ai][1][m][0], u1 = acc[ai][1][m][1];
                f32x2 w_; unsigned lo = pk4_fp8(clamp448(silu_mul(g0[0], u0[0])), clamp448(silu_mul(g0[1], u0[1])), clamp448(silu_mul(g0[2], u0[2])), clamp448(silu_mul(g0[3], u0[3])));
                unsigned hi = pk4_fp8(clamp448(silu_mul(g1[0], u1[0])), clamp448(silu_mul(g1[1], u1[1])), clamp448(silu_mul(g1[2], u1[2])), clamp448(silu_mul(g1[3], u1[3])));
                typedef unsigned u32x2_ __attribute__((ext_vector_type(2))); (void)w_; *(u32x2_*)rowp = (u32x2_){lo, hi}; }
    }
};
constexpr float YSCALE = 32.0f;
struct EpiDown {
    static constexpr bool PERM = true, AFTER_DRAIN = false, HEADPERM = false, PERM16 = true;
    unsigned char* O; const float* gate; int ldc;
    __device__ __forceinline__ void operator()(const f32x4 (&acc)[2][2][4][2], const Unit& u, int wr, int wc, int fr, int fq) const {
        const int row0 = u.pm * BM + wr * 64 + fr, col0 = u.pn * BM + wc * 64 + 16 * fq;
#pragma unroll
        for (int ai = 0; ai < 2; ++ai)
#pragma unroll
            for (int m = 0; m < 4; ++m) { const int row = row0 + ai * HALF + m * 16; const float gt = gate[row] * YSCALE; unsigned char* rowp = O + (size_t)row * ldc + col0;
                unsigned w[4];
#pragma unroll
                for (int bj = 0; bj < 2; ++bj)
#pragma unroll
                    for (int n = 0; n < 2; ++n) { const f32x4 v = acc[ai][bj][m][n] * gt; w[2 * bj + n] = pk4_fp8(clamp448(v[0]), clamp448(v[1]), clamp448(v[2]), clamp448(v[3])); }
                *(u32x4*)rowp = (u32x4){w[0], w[1], w[2], w[3]}; }
    }
};
typedef float f32x2e __attribute__((ext_vector_type(2)));
__device__ __forceinline__ unsigned pk4_fp8(float a, float b, float c, float d);
template <bool F8OUT = false> __device__ __forceinline__ void head_tile_store(const f32x4 (&acc)[2][2][4][2], bf16_t* obase  , int opitch, const float* gain, float scale, const f32x2e* rope, int row0, int fq) {
    asm volatile("" : "+v"(fq), "+v"(row0));
    f32x4 g[2][2];
    if (gain) {
#pragma unroll
        for (int bj = 0; bj < 2; ++bj)
#pragma unroll
            for (int n = 0; n < 2; ++n) g[bj][n] = *(const f32x4*)(gain + 32 * bj + 8 * fq + 4 * n);
    }
#pragma unroll
    for (int ai = 0; ai < 2; ++ai)
#pragma unroll
        for (int m = 0; m < 4; ++m) {
            const int row = row0 + ai * HALF + m * 16;
            f32x4 x[2][2];
#pragma unroll
            for (int bj = 0; bj < 2; ++bj)
#pragma unroll
                for (int n = 0; n < 2; ++n) x[bj][n] = acc[ai][bj][m][n];
            if (gain) {
                float ss = 0.f;
#pragma unroll
                for (int bj = 0; bj < 2; ++bj)
#pragma unroll
                    for (int n = 0; n < 2; ++n) ss += (x[bj][n][0] * x[bj][n][0] + x[bj][n][1] * x[bj][n][1]) + (x[bj][n][2] * x[bj][n][2] + x[bj][n][3] * x[bj][n][3]);
                ss += __shfl_xor(ss, 16); ss += __shfl_xor(ss, 32);
                const float r = scale / sqrtf(ss * (1.f / 64.f) + 1e-6f);
#pragma unroll
                for (int bj = 0; bj < 2; ++bj)
#pragma unroll
                    for (int n = 0; n < 2; ++n) x[bj][n] = x[bj][n] * r * g[bj][n];
            }
            if (rope) {
                const int t = row & 8191; const bool second = (fq & 2) != 0;
#pragma unroll
                for (int bj = 0; bj < 2; ++bj) { const int pos = bj ? (t & 63) : (t >> 6); const f32x2e* tb = rope + pos * 16 + 8 * (fq & 1);
#pragma unroll
                    for (int n = 0; n < 2; ++n)
#pragma unroll
                        for (int e = 0; e < 4; ++e) { const float p = __shfl_xor(x[bj][n][e], 32); const f32x2e cs = tb[4 * n + e]; const float v = x[bj][n][e];
                            x[bj][n][e] = second ? (p * cs.y + v * cs.x) : (v * cs.x - p * cs.y); } }
            }
            if constexpr (F8OUT) { unsigned char* rowp8 = (unsigned char*)obase + (size_t)row * opitch + 8 * fq; typedef unsigned u32x2_ __attribute__((ext_vector_type(2)));
#pragma unroll
                for (int bj = 0; bj < 2; ++bj) *(u32x2_*)(rowp8 + 32 * bj) = (u32x2_){pk4_fp8(x[bj][0][0], x[bj][0][1], x[bj][0][2], x[bj][0][3]), pk4_fp8(x[bj][1][0], x[bj][1][1], x[bj][1][2], x[bj][1][3])};
                continue; }
            bf16_t* rowp = obase + (size_t)row * opitch + 8 * fq;
#pragma unroll
            for (int bj = 0; bj < 2; ++bj) { u32x4 w; w.x = cvt_pk_bf16(x[bj][0][0], x[bj][0][1]); w.y = cvt_pk_bf16(x[bj][0][2], x[bj][0][3]); w.z = cvt_pk_bf16(x[bj][1][0], x[bj][1][1]); w.w = cvt_pk_bf16(x[bj][1][2], x[bj][1][3]);
                *(u32x4*)(rowp + 32 * bj) = w; }
        }
}
__host__ __device__ __forceinline__ int vt_pos(int k) { const int half = k >> 5, k5 = k & 31; return 32 * ((k5 >> 2) & 1) + 16 * half + (k5 & 3) + 4 * (k5 >> 3); }
__device__ __forceinline__ void vt_tile_store(const f32x4 (&acc)[2][2][4][2], unsigned char* VT, int kvh, int row0, int fq) {
    asm volatile("" : "+v"(fq), "+v"(row0));
#pragma unroll
    for (int ai = 0; ai < 2; ++ai)
#pragma unroll
        for (int m = 0; m < 4; ++m) {
            const int row = row0 + ai * HALF + m * 16, b = row >> 13, t = row & 8191;
            unsigned char* col = VT + ((size_t)(b * 2 + kvh) * 64) * 8192 + (t & ~63) + vt_pos(t & 63);
#pragma unroll
            for (int bj = 0; bj < 2; ++bj)
#pragma unroll
                for (int n = 0; n < 2; ++n) { const f32x4 x = acc[ai][bj][m][n]; const unsigned w = pk4_fp8(x[0], x[1], x[2], x[3]); const int d = 32 * bj + 8 * fq + 4 * n;
#pragma unroll
                    for (int e = 0; e < 4; ++e) col[(size_t)(d + e) * 8192] = (unsigned char)(w >> (8 * e)); }
        }
}
struct EpiHeads0 {
    static constexpr bool PERM = true, AFTER_DRAIN = false, HEADPERM = true;
    bf16_t *AQ, *AK, *AV, *BQ, *BK, *BV; const float *aqn, *akn, *bqn, *bkn; const f32x2e* rope; float qscale, aqscale;
    __device__ __forceinline__ void operator()(const f32x4 (&acc)[2][2][4][2], const Unit& u, int wr, int wc, int fr, int fq) const {
        const int row0 = u.pm * BM + wr * 64 + fr, pn = u.pn, hd = 4 * (pn & 1) + wc;
        if (pn < 2)      head_tile_store(acc, AQ + hd * 64, 512, aqn, aqscale, nullptr, row0, fq);
        else if (pn < 4) head_tile_store(acc, AK + hd * 64, 512, akn, 1.0f, nullptr, row0, fq);
        else if (pn < 6) head_tile_store(acc, AV + hd * 64, 512, nullptr, 1.0f, nullptr, row0, fq);
        else if (pn < 8) head_tile_store<true>(acc, (bf16_t*)((unsigned char*)BQ + hd * 64), 512, bqn, 16.f * qscale, rope, row0, fq);
        else if (wc < 2) head_tile_store<true>(acc, (bf16_t*)((unsigned char*)BK + wc * 64), 128, bkn, 1.0f, rope, row0, fq);
        else             vt_tile_store(acc, (unsigned char*)BV, wc - 2, row0, fq);
    }
};
struct EpiHeads1 {
    static constexpr bool PERM = true, AFTER_DRAIN = false, HEADPERM = true;
    bf16_t *CQ, *CK, *CV; const float *cqn, *ckn; float qscale;
    __device__ __forceinline__ void operator()(const f32x4 (&acc)[2][2][4][2], const Unit& u, int wr, int wc, int fr, int fq) const {
        const int row0 = u.pm * BM + wr * 64 + fr, pn = u.pn;
        if (pn < 4)       head_tile_store(acc, CQ + (4 * pn + wc) * 64, 1024, cqn, qscale, nullptr, row0, fq);
        else if (pn == 4) head_tile_store(acc, CK + wc * 64, 256, ckn, 1.0f, nullptr, row0, fq);
        else              head_tile_store(acc, CV + wc * 64, 256, nullptr, 1.0f, nullptr, row0, fq);
    }
};
struct MoeGateUpOrder {
    static constexpr bool GATHER = true;
    int G, c; const PG8_LAS unsigned* rowoff;
    __device__ __forceinline__ unsigned a_off(int ui, int r) const { return rowoff[ui * 256 + r]; }
    __device__ __forceinline__ bool next(int i, Unit& u) const {
        const long L = (long)i * G + c; if (L >= 4096) return false;
        const int e = (int)(L >> 8), t = (int)(L & 255), xcd = t & 7, slot = t >> 3;
        const int pml = 4 * (xcd & 3) + (slot & 3), pn = 8 * (xcd >> 2) + (slot >> 2);
        u.pm = 16 * e + pml; u.pn = pn; u.pb = 16 * e + pn; return true;
    }
    __device__ __forceinline__ void a_ready(const Unit&) const {}
    __device__ __forceinline__ void done(const Unit&) const {}
};
struct MoeDownOrder {
    static constexpr bool GATHER = false;
    int G, c;
    __device__ __forceinline__ bool next(int i, Unit& u) const {
        const long L = (long)i * G + c; if (L >= 1024) return false;
        const int rnd = (int)(L >> 8), t = (int)(L & 255), xcd = t & 7, slot = t >> 3;
        const int e = 4 * rnd + (xcd >> 1), pml = 8 * (xcd & 1) + (slot & 7), pn = slot >> 3;
        u.pm = 16 * e + pml; u.pn = pn; u.pb = 4 * e + pn; return true;
    }
    __device__ __forceinline__ void a_ready(const Unit&) const {}
    __device__ __forceinline__ void done(const Unit&) const {}
};
}

#ifndef PG8_SP2
#define PG8_SP2 true
#endif
#ifndef PG8_ALIGN
#define PG8_ALIGN true
#endif
#ifndef PROBE_MASK
#define PROBE_MASK 0
#endif
#ifndef MK_SINGLE
#define MK_SINGLE 0
#endif

constexpr int NWAVES = 8;
constexpr int NB = 4, SEQ = 8192, DM = 1024, NTOK = NB * SEQ;
constexpr int L0_IN = 2304, L1_IN = 1536, NE = 16, DFF = 2048, CAP = 1024, NPAIR = NB * NE * CAP;
constexpr float RMS_EPS = 1e-6f, LOG2E = 1.4426950408889634f, QSCALE = 0.125f * LOG2E, NEGBIG = -1e30f;
constexpr int N_PHASES = 21;
#ifndef G_P1
#define G_P1 144
#endif
constexpr int CVT1_P6 = 1296, CVT1_P16 = 1296, CVT1_LATE = CVT1_P6 + CVT1_P16;

constexpr size_t MiB = 1u << 20;
constexpr size_t WS_CTL = 0, CTL_ZERO_BYTES = 1 * MiB;
constexpr size_t WS_ROPE = 1 * MiB;
constexpr size_t WS_WIN0 = 2 * MiB, WS_WOUT0 = 7 * MiB, WS_WIN1 = 9 * MiB, WS_WOUT1 = 12 * MiB;
constexpr size_t WS_AFF = 14 * MiB;
constexpr size_t WS_SEL = 16 * MiB;
constexpr size_t WS_IDX = 18 * MiB, WS_GATE = 18 * MiB + 512 * 1024;
constexpr size_t WS_XN = 20 * MiB;
constexpr size_t WS_WGU0 = 84 * MiB, WS_WGU1 = 180 * MiB;
constexpr size_t WS_WDN0 = 148 * MiB, WS_WDN1 = 244 * MiB;
constexpr size_t WS_R = 276 * MiB;
constexpr size_t WS_AQ = WS_R, WS_AK = WS_AQ + 32 * MiB, WS_AV = WS_AK + 32 * MiB, WS_BQ = WS_AV + 32 * MiB, WS_BK = WS_BQ + 32 * MiB, WS_BV = WS_BK + 8 * MiB;
constexpr size_t WS_CQ = WS_R, WS_CK = WS_CQ + 64 * MiB, WS_CV = WS_CK + 16 * MiB;
constexpr size_t WS_O = WS_R + 248 * MiB;
constexpr size_t WS_ST = WS_R + 320 * MiB, WS_ML = WS_R + 384 * MiB;
constexpr size_t WS_XS = WS_R, WS_ACT = WS_R + 64 * MiB, WS_Y = WS_R + 192 * MiB, WS_XN8 = WS_R + 320 * MiB;
constexpr size_t WS_XR = WS_R + 512 * MiB;
constexpr size_t WS_END = WS_XR + 64 * MiB;
static_assert(WS_BV + 8 * MiB <= WS_O && WS_CV + 16 * MiB <= WS_O && WS_O + 64 * MiB <= WS_END, "d_ws map");
constexpr int CW_TMO = 0, CW_BAR = 4096;

constexpr int SCR_BYTES = 147456, LDSCTL_OFF = SCR_BYTES, MISC_OFF = LDSCTL_OFF + 320, LDS_BYTES = SCR_BYTES + 512;

#define GAS __attribute__((address_space(1)))
#define LAS __attribute__((address_space(3)))
typedef unsigned short bf16;
typedef unsigned v4u __attribute__((ext_vector_type(4)));
typedef unsigned v2u __attribute__((ext_vector_type(2)));
typedef int v4i __attribute__((ext_vector_type(4)));
typedef float f32x4 __attribute__((ext_vector_type(4)));
typedef float f32x2 __attribute__((ext_vector_type(2)));
typedef float f32x16 __attribute__((ext_vector_type(16)));
typedef short bf16x8 __attribute__((ext_vector_type(8)));
typedef short s16x4 __attribute__((ext_vector_type(4)));
typedef GAS unsigned gu32;
#define RLX_AGENT __ATOMIC_RELAXED, __HIP_MEMORY_SCOPE_AGENT
#define LDS_WAIT() asm volatile("s_waitcnt lgkmcnt(0)" ::: "memory")
#define VM_WAIT() asm volatile("s_waitcnt vmcnt(0)" ::: "memory")
__device__ __forceinline__ unsigned pkbf(float lo, float hi) { unsigned r; asm volatile("v_cvt_pk_bf16_f32 %0, %1, %2" : "=v"(r) : "v"(lo), "v"(hi)); return r; }
__device__ __forceinline__ float bf_lo(unsigned w) { return __uint_as_float(w << 16); }
__device__ __forceinline__ float bf_hi(unsigned w) { return __uint_as_float(w & 0xffff0000u); }
__device__ __forceinline__ float wave_sum(float v) {
#pragma unroll
    for (int o = 1; o < 64; o <<= 1) v += __shfl_xor(v, o);
    return v;
}

#define XB_TMO      128
#define XB_XCNT(j)  (256  + 64 * (j))
#define XB_XSUB(j)  (1280 + 64 * (j))
#define XB_XGEN(j)  (2304 + 64 * (j))
#define XB_TOP      3328
#define XB_TOPGEN   3392
#define XCD_BAR_WORDS 3456
#define XB_SPIN_CAP (1u << 18)
__device__ __forceinline__ unsigned xb_ld(unsigned* p)              { return __hip_atomic_load(p, __ATOMIC_RELAXED, __HIP_MEMORY_SCOPE_AGENT); }
__device__ __forceinline__ unsigned xb_add(unsigned* p, unsigned v) { return __hip_atomic_fetch_add(p, v, __ATOMIC_RELAXED, __HIP_MEMORY_SCOPE_AGENT); }
__device__ __forceinline__ unsigned xb_xcc_id() { return (unsigned)__builtin_amdgcn_s_getreg((3 << 11) | 20) & 0xFu; }
#define XB_SPIN(cond, bar) do { unsigned _sp = 0; while (cond) { __builtin_amdgcn_s_sleep(1); \
    if ((++_sp & 255u) == 0u) { if (xb_ld(&(bar)[XB_TMO])) break; if (_sp > XB_SPIN_CAP) { atomicAdd(&(bar)[XB_TMO], 1u); break; } } } } while (0)
struct XcdBarrier { unsigned* bar; unsigned x; volatile LAS unsigned* st; };
__device__ __forceinline__ XcdBarrier xcd_barrier_post(unsigned* bar, volatile LAS unsigned* st) {
    XcdBarrier b; b.bar = bar; b.x = xb_xcc_id(); b.st = st;
    if (threadIdx.x == 0) (void)xb_add(&bar[XB_XCNT(b.x)], 1u);
    return b;
}
__device__ __forceinline__ void xcd_barrier_complete(unsigned* bar, unsigned x, unsigned& nloc, unsigned& nx) {
    const unsigned G = gridDim.x * gridDim.y * gridDim.z;
    unsigned sum, cnt, mine, sp = 0u;
    for (;;) {
        sum = 0u; cnt = 0u; mine = 0u;
#pragma unroll
        for (unsigned j = 0; j < 16; ++j) { const unsigned c = xb_ld(&bar[XB_XCNT(j)]); sum += c; cnt += (c > 0u) ? 1u : 0u; mine = (j == x) ? c : mine; }
        if (sum == G) break;
        __builtin_amdgcn_s_sleep(1);
        if ((++sp & 255u) == 0u) { if (xb_ld(&bar[XB_TMO])) break; if (sp > XB_SPIN_CAP) { atomicAdd(&bar[XB_TMO], 1u); break; } }
    }
    nloc = mine > 0u ? mine : 1u; nx = cnt > 0u ? cnt : 1u;
}
__device__ __forceinline__ void xcd_barrier_arrive(const XcdBarrier& b) {
    asm volatile("s_waitcnt vmcnt(0)" ::: "memory");
    __syncthreads();
    if (threadIdx.x == 0) {
        unsigned* bar = b.bar;
        __builtin_amdgcn_s_waitcnt(0);
        unsigned nloc = b.st[0], nx = b.st[1];
        if (nloc == 0u) { xcd_barrier_complete(bar, b.x, nloc, nx); b.st[0] = nloc; b.st[1] = nx; }
        const unsigned old = xb_add(&bar[XB_XSUB(b.x)], 1u);
        const unsigned gen = old / nloc;
        if (old + 1u == (gen + 1u) * nloc) {
            __builtin_amdgcn_fence(__ATOMIC_RELEASE, "agent");
            asm volatile("s_waitcnt vmcnt(0)" ::: "memory");
            (void)xb_add(&bar[XB_TOP], 1u);
        }
        b.st[2] = (gen + 1u) * nx;
    }
}
__device__ __forceinline__ void xcd_barrier_wait(const XcdBarrier& b) {
    if (threadIdx.x == 0) {
        unsigned* bar = b.bar; const unsigned target = b.st[2];
        XB_SPIN(xb_ld(&bar[XB_TOP]) < target, bar);
        __builtin_amdgcn_fence(__ATOMIC_ACQUIRE, "agent");
        asm volatile("s_waitcnt vmcnt(0)" ::: "memory");
    }
    __syncthreads();
}
__device__ __forceinline__ void xcd_barrier(const XcdBarrier& b) { xcd_barrier_arrive(b); xcd_barrier_wait(b); }

__device__ __forceinline__ void cvt_item(const float* __restrict__ src, int K, int N, bf16* dst, int kb, int nb, int drow0, LAS float* scr, int lane) {
    const int k0 = kb * 64, n0 = nb * 64;
    const float* s = src + (size_t)(k0 + (lane >> 4)) * N + n0 + 4 * (lane & 15);
    f32x4 v[16];
#pragma unroll
    for (int i = 0; i < 16; ++i) v[i] = *(const f32x4*)(s + (size_t)(4 * i) * N);
#pragma unroll
    for (int i = 0; i < 16; ++i) { LAS float* p = scr + (4 * i + (lane >> 4)) * 65 + 4 * (lane & 15); p[0] = v[i].x; p[1] = v[i].y; p[2] = v[i].z; p[3] = v[i].w; }
    LDS_WAIT();
    const int c = lane & 7;
#pragma unroll
    for (int j = 0; j < 8; ++j) { const int n = (lane >> 3) + 8 * j; const LAS float* q = scr + (8 * c) * 65 + n;
        v4u o; o.x = pkbf(q[0], q[65]); o.y = pkbf(q[130], q[195]); o.z = pkbf(q[260], q[325]); o.w = pkbf(q[390], q[455]);
        *(v4u*)(dst + (size_t)(drow0 + n) * K + k0 + 8 * c) = o; }
    LDS_WAIT();
}
__device__ __forceinline__ void cvt_item8(const float* __restrict__ src, int K, int N, unsigned char* dst, int kb, int nb, int drow0, float wscale, LAS float* scr, int lane) {
    const int k0 = kb * 64, n0 = nb * 64;
    const float* s = src + (size_t)(k0 + (lane >> 4)) * N + n0 + 4 * (lane & 15);
    f32x4 v[16];
#pragma unroll
    for (int i = 0; i < 16; ++i) v[i] = *(const f32x4*)(s + (size_t)(4 * i) * N);
#pragma unroll
    for (int i = 0; i < 16; ++i) { LAS float* p = scr + (4 * i + (lane >> 4)) * 65 + 4 * (lane & 15); p[0] = v[i].x * wscale; p[1] = v[i].y * wscale; p[2] = v[i].z * wscale; p[3] = v[i].w * wscale; }
    LDS_WAIT();
    const int c = lane & 3;
#pragma unroll
    for (int j = 0; j < 4; ++j) { const int n = (lane >> 2) + 16 * j; const LAS float* q = scr + (16 * c) * 65 + n;
        v4u o; o.x = pg8::pk4_fp8(q[0], q[65], q[130], q[195]); o.y = pg8::pk4_fp8(q[260], q[325], q[390], q[455]);
        o.z = pg8::pk4_fp8(q[520], q[585], q[650], q[715]); o.w = pg8::pk4_fp8(q[780], q[845], q[910], q[975]);
        *(v4u*)(dst + (size_t)(drow0 + n) * K + k0 + 16 * c) = o; }
    LDS_WAIT();
}
struct CvtItem { const float* src; unsigned char* dst; int N, K, which, nb; float wscale; };
__device__ __forceinline__ CvtItem cvt_moe_item(int it, const float* wg, const float* wu, const float* wd, unsigned char* WGU, unsigned char* WDN, int lane) {
    const int which = it >> 11, r = it & 2047, e = r >> 7, q = r & 127; CvtItem c; c.which = which;
    if (which < 2) { const int nb = q & 31, k0 = (q >> 5) * 256; c.nb = nb;
        c.N = DFF; c.K = DM; c.wscale = which ? 64.f / LOG2E : 64.f * LOG2E; c.src = (which ? wu : wg) + (size_t)e * DM * DFF + (size_t)(k0 + 16 * (lane >> 4)) * DFF + nb * 64 + 4 * (lane & 15);
        c.dst = WGU + (size_t)e * 4096 * DM + k0; }
    else { const int nb = q & 15, k0 = (q >> 4) * 256; c.nb = nb;
        c.N = DM; c.K = DFF; c.wscale = 64.f; c.src = wd + (size_t)e * DFF * DM + (size_t)(k0 + 16 * (lane >> 4)) * DM + nb * 64 + 4 * (lane & 15);
        c.dst = WDN + (size_t)e * DM * DFF + k0; }
    return c;
}
#define CVT_LOAD(v, c, s_) do { _Pragma("unroll") for (int i_ = 0; i_ < 16; ++i_) v[i_] = *(const f32x4*)((c).src + (size_t)(64 * (s_) + i_) * (c).N); } while (0)
__device__ __forceinline__ void cvt_pack8(const f32x4 (&v)[16], const CvtItem& c, LAS unsigned char* blk, int s4, int lane) {
    const float w = c.wscale; const int cb = lane & 15, j = 4 * s4 + (lane >> 4);
#pragma unroll
    for (int jn = 0; jn < 4; ++jn) {
        v4u o; o.x = pg8::pk4_fp8(v[0][jn] * w, v[1][jn] * w, v[2][jn] * w, v[3][jn] * w); o.y = pg8::pk4_fp8(v[4][jn] * w, v[5][jn] * w, v[6][jn] * w, v[7][jn] * w);
        o.z = pg8::pk4_fp8(v[8][jn] * w, v[9][jn] * w, v[10][jn] * w, v[11][jn] * w); o.w = pg8::pk4_fp8(v[12][jn] * w, v[13][jn] * w, v[14][jn] * w, v[15][jn] * w);
        *(LAS v4u*)(blk + (4 * cb + jn) * 256 + ((j ^ cb) * 16)) = o; }
}
__device__ __forceinline__ void cvt_flush8(const CvtItem& c, const LAS unsigned char* blk, int lane) {
    LDS_WAIT();
#pragma unroll
    for (int t = 0; t < 16; ++t) { const int idx = 64 * t + lane, n = idx >> 4, pc = idx & 15, nn = c.nb * 64 + n;
        const size_t row = (c.which < 2) ? (size_t)((nn >> 7) * 256 + (nn & 127) + c.which * 128) : (size_t)nn;
        *(v4u*)(c.dst + row * c.K + 16 * pc) = *(const LAS v4u*)(blk + n * 256 + ((pc ^ ((n >> 2) & 15)) * 16)); }
    LDS_WAIT();
}
struct CvtSrc { const float *wg, *wu, *wd; unsigned char *WGU, *WDN; int it0, n; };
__device__ __forceinline__ CvtItem cvt_moe_item2(int j, const CvtSrc& A, const CvtSrc& B, int lane) {
    return (j < A.n) ? cvt_moe_item(A.it0 + j, A.wg, A.wu, A.wd, A.WGU, A.WDN, lane) : cvt_moe_item(B.it0 + (j - A.n), B.wg, B.wu, B.wd, B.WGU, B.WDN, lane);
}
__device__ __forceinline__ void cvt_moe_pipe2(const CvtSrc& A, const CvtSrc& B, LAS float* scr, int gw, int NGW, int lane) {
    LAS unsigned char* blk = (LAS unsigned char*)scr;
    f32x4 va[16], vb[16]; CvtItem c, cn;
    const int it1 = A.n + B.n; int it = gw;
    if (it < it1) { c = cvt_moe_item2(it, A, B, lane); CVT_LOAD(va, c, 0); }
    while (it < it1) {
        const int i1 = it + NGW; const bool more = i1 < it1;
        CVT_LOAD(vb, c, 1); cvt_pack8(va, c, blk, 0, lane);
        CVT_LOAD(va, c, 2); cvt_pack8(vb, c, blk, 1, lane);
        CVT_LOAD(vb, c, 3); cvt_pack8(va, c, blk, 2, lane);
        if (more) { cn = cvt_moe_item2(i1, A, B, lane); CVT_LOAD(va, cn, 0); }
        cvt_pack8(vb, c, blk, 3, lane);
        cvt_flush8(c, blk, lane);
        if (more) c = cn;
        it = i1;
    }
}
__device__ __forceinline__ void cvt_moe(const float* wg, const float* wu, const float* wd, unsigned char* WGU, unsigned char* WDN, LAS float* scr, int gw, int NGW, int lane, int it0 = 0, int it1 = 3 * 2048) {
    const CvtSrc A{wg, wu, wd, WGU, WDN, it0, it1 - it0}, B{wg, wu, wd, WGU, WDN, 0, 0};
    cvt_moe_pipe2(A, B, scr, gw, NGW, lane);
}
__device__ __forceinline__ void cvt_dense8(const float* w, int K, int N, unsigned char* dst, LAS float* scr, int gw, int NGW, int lane) {
    const int nnb = N / 64, items = (K / 64) * nnb;
    for (int it = gw; it < items; it += NGW) cvt_item8(w, K, N, dst, it / nnb, it % nnb, (it % nnb) * 64, 64.f, scr, lane);
}
__device__ __forceinline__ void cvt_dense(const float* w, int K, int N, bf16* dst, LAS float* scr, int gw, int NGW, int lane) {
    const int nnb = N / 64, items = (K / 64) * nnb;
    for (int it = gw; it < items; it += NGW) cvt_item(w, K, N, dst, it / nnb, it % nnb, (it % nnb) * 64, scr, lane);
}
__device__ __forceinline__ void rms_row2_to_fp8(const float* xrow, const float* g, unsigned char* orow, int lane) {
    const f32x4* xr = (const f32x4*)xrow + lane; const f32x4* gr = (const f32x4*)g + lane;
    f32x4 v[2][4]; float s0 = 0.f, s1 = 0.f;
#pragma unroll
    for (int j = 0; j < 4; ++j) { v[0][j] = xr[64 * j]; v[1][j] = xr[256 + 64 * j]; }
#pragma unroll
    for (int j = 0; j < 4; ++j) { s0 += (v[0][j].x * v[0][j].x + v[0][j].y * v[0][j].y) + (v[0][j].z * v[0][j].z + v[0][j].w * v[0][j].w); s1 += (v[1][j].x * v[1][j].x + v[1][j].y * v[1][j].y) + (v[1][j].z * v[1][j].z + v[1][j].w * v[1][j].w); }
    const float r0 = 1.0f / sqrtf(wave_sum(s0) * (1.f / DM) + RMS_EPS), r1 = 1.0f / sqrtf(wave_sum(s1) * (1.f / DM) + RMS_EPS);
    unsigned* o4 = (unsigned*)orow + lane;
#pragma unroll
    for (int j = 0; j < 4; ++j) { const f32x4 gg = gr[64 * j];
        o4[64 * j] = pg8::pk4_fp8(v[0][j].x * r0 * gg.x, v[0][j].y * r0 * gg.y, v[0][j].z * r0 * gg.z, v[0][j].w * r0 * gg.w);
        o4[256 + 64 * j] = pg8::pk4_fp8(v[1][j].x * r1 * gg.x, v[1][j].y * r1 * gg.y, v[1][j].z * r1 * gg.z, v[1][j].w * r1 * gg.w); }
}
__device__ __forceinline__ void rope_table(f32x2* tab, int j) {
    double th = 1.0;
    for (int k = 0; k < j; ++k) th *= 0.5623413251903491;
    const double x2 = th * th; double c = 1.0, s = th, tc = 1.0, ts = th;
#pragma unroll
    for (int n = 1; n <= 12; ++n) { tc *= -x2 * (1.0 / (double)((2 * n - 1) * (2 * n))); ts *= -x2 * (1.0 / (double)((2 * n) * (2 * n + 1))); c += tc; s += ts; }
    double cr = 1.0, sr = 0.0;
    for (int p = 0; p < 128; ++p) { tab[p * 16 + j] = (f32x2){(float)cr, (float)sr}; const double nc = cr * c - sr * s, ns = sr * c + cr * s; cr = nc; sr = ns; }
}
__device__ __forceinline__ void head_norm8(float (&y)[8], const float* gain, int li, float scale) {
    float ss = 0.f;
#pragma unroll
    for (int i = 0; i < 8; ++i) ss += y[i] * y[i];
    ss += __shfl_xor(ss, 1); ss += __shfl_xor(ss, 2); ss += __shfl_xor(ss, 4);
    const float rstd = scale / sqrtf(ss * (1.f / 64.f) + RMS_EPS);
    const f32x4 g0 = *(const f32x4*)(gain + 8 * li), g1 = *(const f32x4*)(gain + 8 * li + 4);
    y[0] *= rstd * g0.x; y[1] *= rstd * g0.y; y[2] *= rstd * g0.z; y[3] *= rstd * g0.w; y[4] *= rstd * g1.x; y[5] *= rstd * g1.y; y[6] *= rstd * g1.z; y[7] *= rstd * g1.w;
}
__device__ __forceinline__ void unpack8(const v4u w, float (&y)[8]) { y[0] = bf_lo(w.x); y[1] = bf_hi(w.x); y[2] = bf_lo(w.y); y[3] = bf_hi(w.y); y[4] = bf_lo(w.z); y[5] = bf_hi(w.z); y[6] = bf_lo(w.w); y[7] = bf_hi(w.w); }
__device__ __forceinline__ v4u pack8(const float (&y)[8]) { v4u w; w.x = pkbf(y[0], y[1]); w.y = pkbf(y[2], y[3]); w.z = pkbf(y[4], y[5]); w.w = pkbf(y[6], y[7]); return w; }
__device__ __forceinline__ void rope8(float (&y)[8], const f32x2* rope, int li, int t) {
    float py[8];
#pragma unroll
    for (int i = 0; i < 8; ++i) py[i] = __shfl_xor(y[i], 2);
    const int pos = (li & 4) ? (t & 63) : (t >> 6);
    const f32x2* tb = rope + pos * 16 + 8 * (li & 1);
    const bool second = (li & 2) != 0;
#pragma unroll
    for (int i = 0; i < 8; ++i) { const f32x2 cs = tb[i]; y[i] = second ? (py[i] * cs.y + y[i] * cs.x) : (y[i] * cs.x - py[i] * cs.y); }
}
constexpr int WT_PITCH = 1028;
__device__ __forceinline__ void norm_router_table(const float* g, const float* Wr, LAS float* WT, int tid) {
    for (int idx = tid; idx < NE * DM; idx += NWAVES * 64) { const int e = idx & 15, d = idx >> 4; WT[e * WT_PITCH + ((d >> 3) & 3) * 256 + (d >> 5) * 8 + (d & 7)] = Wr[idx] * g[d]; }
}
__device__ __forceinline__ void norm_router_phase(const bf16* x1, const float* g, const float* Wr, unsigned char* XN8, float* AFF, LAS float* WT, int gw, int NGW, int lane, int tid, bool table_ready) {
    if (!table_ready) norm_router_table(g, Wr, WT, tid);
    __syncthreads();
    float gg[16];
#pragma unroll
    for (int j = 0; j < 2; ++j) { const f32x4 a = *(const f32x4*)(g + 512 * j + 8 * lane), b = *(const f32x4*)(g + 512 * j + 8 * lane + 4);
        gg[8 * j] = a.x; gg[8 * j + 1] = a.y; gg[8 * j + 2] = a.z; gg[8 * j + 3] = a.w; gg[8 * j + 4] = b.x; gg[8 * j + 5] = b.y; gg[8 * j + 6] = b.z; gg[8 * j + 7] = b.w; }
    const int ti = lane & 15, kq = lane >> 4;
    const LAS float* wrow = WT + ti * WT_PITCH + kq * 256;
    for (int grp = gw; grp < NTOK / 16; grp += NGW) {
        const int row0 = 16 * grp;
        const bf16* xp = x1 + (size_t)(row0 + ti) * DM + 8 * kq;
        f32x4 acc0 = {0.f, 0.f, 0.f, 0.f}, acc1 = acc0; float ss = 0.f;
        v4u cur[8], nxt[8];
#pragma unroll
        for (int i = 0; i < 8; ++i) cur[i] = *(const v4u*)(xp + 32 * i);
#pragma unroll 1
        for (int blk8 = 0; blk8 < 4; ++blk8) {
            if (blk8 < 3) {
#pragma unroll
                for (int i = 0; i < 8; ++i) nxt[i] = *(const v4u*)(xp + 32 * (8 * blk8 + 8 + i)); }
#pragma unroll
            for (int i = 0; i < 8; ++i) {
                float f[8]; unpack8(cur[i], f);
                const f32x4 wa = *(const LAS f32x4*)(wrow + 8 * (8 * blk8 + i)), wb = *(const LAS f32x4*)(wrow + 8 * (8 * blk8 + i) + 4);
                ss += (f[0] * f[0] + f[1] * f[1]) + (f[2] * f[2] + f[3] * f[3]) + (f[4] * f[4] + f[5] * f[5]) + (f[6] * f[6] + f[7] * f[7]);
                acc0 = __builtin_amdgcn_mfma_f32_16x16x4f32(wa.x, f[0], acc0, 0, 0, 0); acc1 = __builtin_amdgcn_mfma_f32_16x16x4f32(wa.y, f[1], acc1, 0, 0, 0);
                acc0 = __builtin_amdgcn_mfma_f32_16x16x4f32(wa.z, f[2], acc0, 0, 0, 0); acc1 = __builtin_amdgcn_mfma_f32_16x16x4f32(wa.w, f[3], acc1, 0, 0, 0);
                acc0 = __builtin_amdgcn_mfma_f32_16x16x4f32(wb.x, f[4], acc0, 0, 0, 0); acc1 = __builtin_amdgcn_mfma_f32_16x16x4f32(wb.y, f[5], acc1, 0, 0, 0);
                acc0 = __builtin_amdgcn_mfma_f32_16x16x4f32(wb.z, f[6], acc0, 0, 0, 0); acc1 = __builtin_amdgcn_mfma_f32_16x16x4f32(wb.w, f[7], acc1, 0, 0, 0); }
            if (blk8 < 3) {
#pragma unroll
                for (int i = 0; i < 8; ++i) cur[i] = nxt[i]; }
        }
        ss += __shfl_xor(ss, 16); ss += __shfl_xor(ss, 32);
        const float rstd = 1.0f / sqrtf(ss * (1.f / DM) + RMS_EPS);
        float lg[4], mx;
#pragma unroll
        for (int r = 0; r < 4; ++r) lg[r] = (acc0[r] + acc1[r]) * rstd;
        mx = fmaxf(fmaxf(lg[0], lg[1]), fmaxf(lg[2], lg[3])); mx = fmaxf(mx, __shfl_xor(mx, 16)); mx = fmaxf(mx, __shfl_xor(mx, 32));
        float ex[4], sm = 0.f;
#pragma unroll
        for (int r = 0; r < 4; ++r) { ex[r] = __builtin_amdgcn_exp2f((lg[r] - mx) * LOG2E); sm += ex[r]; }
        sm += __shfl_xor(sm, 16); sm += __shfl_xor(sm, 32);
        { const int row = row0 + ti; const float inv = 1.0f / sm;
#pragma unroll
          for (int r = 0; r < 4; ++r) AFF[((size_t)(4 * kq + r) * NB + (row >> 13)) * SEQ + (row & (SEQ - 1))] = ex[r] * inv; }
        const unsigned rbits = __float_as_uint(rstd);
        v4u xa[16], xb[16];
#pragma unroll
        for (int i = 0; i < 16; ++i) { const bf16* xr = x1 + (size_t)(row0 + i) * DM + 8 * lane; xa[i] = *(const v4u*)xr; xb[i] = *(const v4u*)(xr + 512); }
#pragma unroll
        for (int i = 0; i < 16; ++i) {
            const float rs = __uint_as_float((unsigned)__builtin_amdgcn_readlane((int)rbits, i));
            float v[16]; { float t[8]; unpack8(xa[i], t);
#pragma unroll
                for (int j = 0; j < 8; ++j) v[j] = t[j] * (rs * gg[j]);
                unpack8(xb[i], t);
#pragma unroll
                for (int j = 0; j < 8; ++j) v[8 + j] = t[j] * (rs * gg[8 + j]); }
            unsigned char* o = XN8 + (size_t)(row0 + i) * DM + 8 * lane;
            *(v2u*)o = (v2u){pg8::pk4_fp8(v[0], v[1], v[2], v[3]), pg8::pk4_fp8(v[4], v[5], v[6], v[7])};
            *(v2u*)(o + 512) = (v2u){pg8::pk4_fp8(v[8], v[9], v[10], v[11]), pg8::pk4_fp8(v[12], v[13], v[14], v[15])};
        }
    }
}
__device__ __forceinline__ void topk_phase(const float* AFF, int* IDX, float* GATE, int* SEL, LAS unsigned* sc, int G, int blk, int tid, int lane, int wave) {
    for (int prob = blk; prob < NE * NB; prob += G) {
        const int e = prob >> 2, b = prob & 3;
        const v4u* a = (const v4u*)(AFF + (size_t)prob * SEQ) + 4 * tid;
        unsigned u[16];
#pragma unroll
        for (int j = 0; j < 4; ++j) { const v4u w = a[j]; u[4 * j] = w.x; u[4 * j + 1] = w.y; u[4 * j + 2] = w.z; u[4 * j + 3] = w.w; }
        unsigned prefix = 0u; int it = 0;
        for (int bit = 30; bit >= -1; --bit, ++it) {
            const unsigned cand = bit >= 0 ? (prefix | (1u << bit)) : prefix + 1u;
            int c = 0;
#pragma unroll
            for (int i = 0; i < 16; ++i) c += (int)__builtin_popcountll(__ballot(u[i] >= cand));
            if (lane == 0) sc[(it & 1) * 8 + wave] = (unsigned)c;
            __syncthreads();
            unsigned tot = 0u;
#pragma unroll
            for (int w = 0; w < 8; ++w) tot += sc[(it & 1) * 8 + w];
            if (bit >= 0) { if (tot >= (unsigned)CAP) prefix = cand; } else { sc[16] = tot; }
        }
        __syncthreads();
        const unsigned T = prefix; const int n_gt = (int)sc[16], need_eq = CAP - n_gt;
        int cg = 0, ce = 0;
#pragma unroll
        for (int i = 0; i < 16; ++i) { cg += (u[i] > T) ? 1 : 0; ce += (u[i] == T) ? 1 : 0; }
        const int pack = cg | (ce << 16); int x = pack;
#pragma unroll
        for (int o = 1; o < 64; o <<= 1) { const int y = __shfl_up(x, o); if (lane >= o) x += y; }
        if (lane == 63) sc[32 + wave] = (unsigned)x;
        __syncthreads();
        int base = 0;
        for (int w = 0; w < wave; ++w) base += (int)sc[32 + w];
        const int excl = base + x - pack; int g = excl & 0xffff, q = excl >> 16;
        int sl[16];
#pragma unroll
        for (int i = 0; i < 16; ++i) {
            int s = -1;
            if (u[i] > T) { s = g + (q < need_eq ? q : need_eq); ++g; }
            else if (u[i] == T) { if (q < need_eq) s = g + q; ++q; }
            sl[i] = s;
            if (s >= 0) { IDX[(size_t)prob * CAP + s] = 16 * tid + i; GATE[(size_t)prob * CAP + s] = __uint_as_float(u[i]); }
        }
        v4i* so = (v4i*)(SEL + ((size_t)b * NE + e) * SEQ) + 4 * tid;
#pragma unroll
        for (int j = 0; j < 4; ++j) so[j] = (v4i){sl[4 * j], sl[4 * j + 1], sl[4 * j + 2], sl[4 * j + 3]};
        __syncthreads();
    }
}
__device__ __forceinline__ void gather_phase(const unsigned char* XN8, const int* IDX, unsigned char* XS, int gw, int NGW, int lane) {
    for (int row = gw; row < NPAIR; row += NGW) {
        const int b = (row >> 10) & 3, tok = IDX[row];
        *((v4u*)(XS + (size_t)row * DM) + lane) = *((const v4u*)(XN8 + ((size_t)b * SEQ + tok) * DM) + lane);
    }
}
__device__ __forceinline__ void unpack8_fp8(const v2u w, float (&y)[8]) {
    const auto a = __builtin_amdgcn_cvt_pk_f32_fp8((int)w.x, false), b = __builtin_amdgcn_cvt_pk_f32_fp8((int)w.x, true), c = __builtin_amdgcn_cvt_pk_f32_fp8((int)w.y, false), d = __builtin_amdgcn_cvt_pk_f32_fp8((int)w.y, true);
    y[0] = a[0]; y[1] = a[1]; y[2] = b[0]; y[3] = b[1]; y[4] = c[0]; y[5] = c[1]; y[6] = d[0]; y[7] = d[1]; }
__device__ __forceinline__ void combine_phase(bf16* x, const unsigned char* Y  , const int* SEL, const float* g, bf16* XN, float* fout, int gw, int NGW, int lane) {
    constexpr int R = 4;
    for (int row0 = R * gw; row0 < NTOK; row0 += R * NGW) {
        const int b = row0 >> 13, s0 = row0 & (SEQ - 1);
        bf16* xr = x + (size_t)row0 * DM + 8 * lane;
        v4u w0[R], w1[R]; int sel[R];
        const int* selp = SEL + ((size_t)b * NE + (lane & 15)) * SEQ + s0;
#pragma unroll
        for (int r = 0; r < R; ++r) { w0[r] = *(const v4u*)(xr + (size_t)r * DM); w1[r] = *(const v4u*)(xr + (size_t)r * DM + 512); sel[r] = selp[r]; }
        float a[R][16]; unsigned mk[R];
#pragma unroll
        for (int r = 0; r < R; ++r) { float t[8]; unpack8(w0[r], t);
#pragma unroll
            for (int i = 0; i < 8; ++i) a[r][i] = t[i];
            unpack8(w1[r], t);
#pragma unroll
            for (int i = 0; i < 8; ++i) a[r][8 + i] = t[i];
            mk[r] = (unsigned)__ballot(sel[r] >= 0) & 0xffffu; }
        constexpr int NI = 3;
        { v2u y0[NI][R], y1[NI][R];
#pragma unroll
          for (int it = 0; it < NI; ++it)
#pragma unroll
            for (int r = 0; r < R; ++r) {
                const bool h = mk[r] != 0u; const int e = h ? __builtin_ctz(mk[r]) : 0; const int sl = __builtin_amdgcn_readlane(sel[r], e); mk[r] &= mk[r] - 1u;
                y0[it][r] = (v2u){0u, 0u}; y1[it][r] = y0[it][r];
                if (h) { const unsigned char* yr = Y + (((size_t)e * NB + b) * CAP + sl) * DM + 8 * lane; y0[it][r] = *(const v2u*)yr; y1[it][r] = *(const v2u*)(yr + 512); }
            }
#pragma unroll
          for (int it = 0; it < NI; ++it)
#pragma unroll
            for (int r = 0; r < R; ++r) { float t[8]; unpack8_fp8(y0[it][r], t);
#pragma unroll
                for (int i = 0; i < 8; ++i) a[r][i] += t[i] * (1.0f / pg8::YSCALE);
                unpack8_fp8(y1[it][r], t);
#pragma unroll
                for (int i = 0; i < 8; ++i) a[r][8 + i] += t[i] * (1.0f / pg8::YSCALE); } }
        while (mk[0] | mk[1] | mk[2] | mk[3]) {
            v2u y0[R], y1[R];
#pragma unroll
            for (int r = 0; r < R; ++r) {
                const bool h = mk[r] != 0u; const int e = h ? __builtin_ctz(mk[r]) : 0; const int sl = __builtin_amdgcn_readlane(sel[r], e); mk[r] &= mk[r] - 1u;
                y0[r] = (v2u){0u, 0u}; y1[r] = y0[r];
                if (h) { const unsigned char* yr = Y + (((size_t)e * NB + b) * CAP + sl) * DM + 8 * lane; y0[r] = *(const v2u*)yr; y1[r] = *(const v2u*)(yr + 512); }
            }
#pragma unroll
            for (int r = 0; r < R; ++r) { float t[8]; unpack8_fp8(y0[r], t);
#pragma unroll
                for (int i = 0; i < 8; ++i) a[r][i] += t[i] * (1.0f / pg8::YSCALE);
                unpack8_fp8(y1[r], t);
#pragma unroll
                for (int i = 0; i < 8; ++i) a[r][8 + i] += t[i] * (1.0f / pg8::YSCALE); }
        }
#pragma unroll
        for (int r = 0; r < R; ++r) {
            float (&v)[16] = a[r]; const int row = row0 + r;
            if (fout) { float* o = fout + (size_t)row * DM + 8 * lane;
                *(f32x4*)o = (f32x4){v[0], v[1], v[2], v[3]}; *(f32x4*)(o + 4) = (f32x4){v[4], v[5], v[6], v[7]}; *(f32x4*)(o + 512) = (f32x4){v[8], v[9], v[10], v[11]}; *(f32x4*)(o + 516) = (f32x4){v[12], v[13], v[14], v[15]}; }
            else {
                bf16* xo = x + (size_t)row * DM + 8 * lane;
                { float t[8];
#pragma unroll
                  for (int i = 0; i < 8; ++i) t[i] = v[i];
                  *(v4u*)xo = pack8(t);
#pragma unroll
                  for (int i = 0; i < 8; ++i) t[i] = v[8 + i];
                  *(v4u*)(xo + 512) = pack8(t); }
                float ss = 0.f;
#pragma unroll
                for (int i = 0; i < 16; ++i) ss += v[i] * v[i];
                const float rstd = 1.0f / sqrtf(wave_sum(ss) * (1.f / DM) + RMS_EPS);
                const f32x4 g0 = *(const f32x4*)(g + 8 * lane), g1 = *(const f32x4*)(g + 8 * lane + 4), g2 = *(const f32x4*)(g + 512 + 8 * lane), g3 = *(const f32x4*)(g + 516 + 8 * lane);
                unsigned char* o = (unsigned char*)XN + (size_t)row * DM + 8 * lane;
                *(v2u*)o = (v2u){pg8::pk4_fp8(v[0] * rstd * g0.x, v[1] * rstd * g0.y, v[2] * rstd * g0.z, v[3] * rstd * g0.w), pg8::pk4_fp8(v[4] * rstd * g1.x, v[5] * rstd * g1.y, v[6] * rstd * g1.z, v[7] * rstd * g1.w)};
                *(v2u*)(o + 512) = (v2u){pg8::pk4_fp8(v[8] * rstd * g2.x, v[9] * rstd * g2.y, v[10] * rstd * g2.z, v[11] * rstd * g2.w), pg8::pk4_fp8(v[12] * rstd * g3.x, v[13] * rstd * g3.y, v[14] * rstd * g3.z, v[15] * rstd * g3.w)};
            }
        }
    }
}

__device__ __forceinline__ int t5_bucket(int rel) {
    const int n = rel < 0 ? -rel : rel; int b = rel > 0 ? 16 : 0;
    if (n < 8) return b + n;
    b += 8 + (n >= 15) + (n >= 27) + (n >= 50) + (n >= 91) + (n >= 166) + (n >= 305) + (n >= 559);
    return b;
}
typedef short v4i16_t __attribute__((ext_vector_type(4)));
constexpr float KAPPA = 128.0f / 65535.0f, KAPPA_INV = 65535.0f / 128.0f;
__device__ __forceinline__ float xhalf_max(float x) { const auto rr = __builtin_amdgcn_permlane32_swap(__float_as_uint(x), __float_as_uint(x), false, false); return fmaxf(__uint_as_float(rr[0]), __uint_as_float(rr[1])); }
__device__ __forceinline__ float xhalf_sum(float x) { const auto rr = __builtin_amdgcn_permlane32_swap(__float_as_uint(x), __float_as_uint(x), false, false); return __uint_as_float(rr[0]) + __uint_as_float(rr[1]); }
__device__ __forceinline__ void band_branch(f32x16& o0, f32x16& o1, float& m, float& l, const bf16x8 (&qf)[4],
        const bf16* Kb, int kpitch, const bf16* Vb, int vpitch, int dil, int res, int L, int kb_first, int ntiles,
        const LAS float* tab, int tboff, LAS unsigned char* vst, int lane, float unscale = 1.0f) {
    int kt_lo = 0, kt_hi = ntiles;
    if (kb_first < 0) kt_lo = (-kb_first) >> 5;
    { const int mx = (L - kb_first) >> 5; if (mx < kt_hi) kt_hi = mx; }
    const int i5 = lane & 31, hh = lane >> 5;
    const int pi = (i5 & 0x13) | (((i5 >> 2) & 1) << 3) | (((i5 >> 3) & 1) << 2);
    const int vr = lane >> 3, vc = lane & 7;
    LAS unsigned char* kst = vst + 4096;
    const LAS unsigned char* trb = vst + (8 * hh + ((lane & 15) >> 2)) * 128 + (16 * ((lane >> 4) & 1) + 4 * (lane & 3)) * 2;
    const LAS unsigned char* krd = kst + pi * 128;
    v4u kn[4], vn[4];
#define BA_LOAD(kn, vn, kt_) do { const int kb_ = kb_first + 32 * (kt_); \
        _Pragma("unroll") for (int ii = 0; ii < 4; ++ii) { const size_t row_ = (size_t)(res + dil * (kb_ + vr + 8 * ii)); \
            kn[ii] = *(const v4u*)(Kb + row_ * kpitch + 8 * vc); vn[ii] = *(const v4u*)(Vb + row_ * vpitch + 8 * vc); } } while (0)
#define BA_TR(off_) __builtin_bit_cast(s16x4, __builtin_amdgcn_ds_read_tr16_b64_v4i16((LAS v4i16_t*)(trb + (off_))))
#define BA_VF(i_) (bf16x8){vt[i_][0], vt[i_][1], vt[i_][2], vt[i_][3], vt[(i_) + 1][0], vt[(i_) + 1][1], vt[(i_) + 1][2], vt[(i_) + 1][3]}
    if (kt_lo < kt_hi) BA_LOAD(kn, vn, kt_lo);
    for (int kt = kt_lo; kt < kt_hi; ++kt) {
#pragma unroll
        for (int ii = 0; ii < 4; ++ii) { const int r_ = vr + 8 * ii; *(LAS v4u*)(kst + r_ * 128 + ((vc ^ (r_ & 7)) * 16)) = kn[ii]; *(LAS v4u*)(vst + r_ * 128 + vc * 16) = vn[ii]; }
        if (kt + 1 < kt_hi) BA_LOAD(kn, vn, kt + 1);
        bf16x8 kf[4];
#pragma unroll
        for (int d0 = 0; d0 < 4; ++d0) kf[d0] = *(const LAS bf16x8*)(krd + (((2 * d0 + hh) ^ (pi & 7)) * 16));
        const LAS float* tp = tab + (kb_first + 32 * kt + tboff);
        f32x16 s;
#pragma unroll
        for (int r = 0; r < 16; ++r) s[r] = tp[(r & 7) + 16 * (r >> 3)];
        s16x4 vt[8];
#pragma unroll
        for (int i = 0; i < 8; ++i) vt[i] = BA_TR((i >> 2) * 2048 + ((i >> 1) & 1) * 64 + (i & 1) * 512);
        __builtin_amdgcn_sched_barrier(0);
#pragma unroll
        for (int d0 = 0; d0 < 4; ++d0) s = __builtin_amdgcn_mfma_f32_32x32x16_bf16(kf[d0], qf[d0], s, 0, 0, 0);
        __builtin_amdgcn_sched_barrier(0);
        if (unscale != 1.0f) {
#pragma unroll
            for (int r = 0; r < 16; ++r) s[r] *= unscale; }
        float mx = fmaxf(s[0], s[1]);
#pragma unroll
        for (int r = 2; r < 16; ++r) mx = fmaxf(mx, s[r]);
        mx = xhalf_max(mx);
        if (__any(mx > m)) {
            const float mn = fmaxf(m, mx), f = __builtin_amdgcn_exp2f(m - mn); m = mn; l *= f;
#pragma unroll
            for (int r = 0; r < 16; ++r) { o0[r] *= f; o1[r] *= f; }
        }
        float ps = 0.f;
#pragma unroll
        for (int r = 0; r < 16; ++r) { s[r] = __builtin_amdgcn_exp2f(s[r] - m); ps += s[r]; }
        l += ps;
        v4u p0, p1;
        p0.x = pkbf(s[0], s[1]); p0.y = pkbf(s[2], s[3]); p0.z = pkbf(s[4], s[5]); p0.w = pkbf(s[6], s[7]);
        p1.x = pkbf(s[8], s[9]); p1.y = pkbf(s[10], s[11]); p1.z = pkbf(s[12], s[13]); p1.w = pkbf(s[14], s[15]);
        const bf16x8 pk0 = __builtin_bit_cast(bf16x8, p0), pk1 = __builtin_bit_cast(bf16x8, p1);
        o0 = __builtin_amdgcn_mfma_f32_32x32x16_bf16(BA_VF(0), pk0, o0, 0, 0, 0); o1 = __builtin_amdgcn_mfma_f32_32x32x16_bf16(BA_VF(2), pk0, o1, 0, 0, 0);
        o0 = __builtin_amdgcn_mfma_f32_32x32x16_bf16(BA_VF(4), pk1, o0, 0, 0, 0); o1 = __builtin_amdgcn_mfma_f32_32x32x16_bf16(BA_VF(6), pk1, o1, 0, 0, 0);
    }
#undef BA_VF
#undef BA_TR
#undef BA_LOAD
}
__device__ __forceinline__ void band_branch_fast(f32x16& o0, f32x16& o1, f32x4& lsum, unsigned& orw, const bf16x8 (&qf)[4],
        const bf16* Kb, int kpitch, const bf16* Vb, int vpitch, int dil, int res, int L, int kb_first, int ntiles,
        const LAS float* tab, int tboff, LAS unsigned char* vst, int lane) {
    const unsigned one2 = ((lane & 15) == ((lane >> 4) & 1)) ? 0x3F803F80u : 0u;
    const bf16x8 onesA = __builtin_bit_cast(bf16x8, (v4u){one2, one2, one2, one2});
    int kt_lo = 0, kt_hi = ntiles;
    if (kb_first < 0) kt_lo = (-kb_first) >> 5;
    { const int mx = (L - kb_first) >> 5; if (mx < kt_hi) kt_hi = mx; }
    const int i5 = lane & 31, hh = lane >> 5;
    const int pi = (i5 & 0x13) | (((i5 >> 2) & 1) << 3) | (((i5 >> 3) & 1) << 2);
    const int vr = lane >> 3, vc = lane & 7;
    LAS unsigned char* kst = vst + 4096;
    const LAS unsigned char* trb = vst + (8 * hh + ((lane & 15) >> 2)) * 128 + (16 * ((lane >> 4) & 1) + 4 * (lane & 3)) * 2;
    const LAS unsigned char* krd = kst + pi * 128;
    v4u kn[4], vn[4];
#define BA_LOAD(kn, vn, kt_) do { const int kb_ = kb_first + 32 * (kt_); \
        _Pragma("unroll") for (int ii = 0; ii < 4; ++ii) { const size_t row_ = (size_t)(res + dil * (kb_ + vr + 8 * ii)); \
            kn[ii] = *(const v4u*)(Kb + row_ * kpitch + 8 * vc); vn[ii] = *(const v4u*)(Vb + row_ * vpitch + 8 * vc); } } while (0)
#define BA_TR(off_) __builtin_bit_cast(s16x4, __builtin_amdgcn_ds_read_tr16_b64_v4i16((LAS v4i16_t*)(trb + (off_))))
#define BA_VF(i_) (bf16x8){vt[i_][0], vt[i_][1], vt[i_][2], vt[i_][3], vt[(i_) + 1][0], vt[(i_) + 1][1], vt[(i_) + 1][2], vt[(i_) + 1][3]}
    if (kt_lo < kt_hi) BA_LOAD(kn, vn, kt_lo);
    for (int kt = kt_lo; kt < kt_hi; ++kt) {
#pragma unroll
        for (int ii = 0; ii < 4; ++ii) { const int r_ = vr + 8 * ii; *(LAS v4u*)(kst + r_ * 128 + ((vc ^ (r_ & 7)) * 16)) = kn[ii]; *(LAS v4u*)(vst + r_ * 128 + vc * 16) = vn[ii]; }
        if (kt + 1 < kt_hi) BA_LOAD(kn, vn, kt + 1);
        bf16x8 kf[4];
#pragma unroll
        for (int d0 = 0; d0 < 4; ++d0) kf[d0] = *(const LAS bf16x8*)(krd + (((2 * d0 + hh) ^ (pi & 7)) * 16));
        const LAS float* tp = tab + (kb_first + 32 * kt + tboff);
        f32x16 s;
#pragma unroll
        for (int r = 0; r < 16; ++r) s[r] = tp[(r & 7) + 16 * (r >> 3)];
        s16x4 vt[8];
#pragma unroll
        for (int i = 0; i < 8; ++i) vt[i] = BA_TR((i >> 2) * 2048 + ((i >> 1) & 1) * 64 + (i & 1) * 512);
        __builtin_amdgcn_sched_barrier(0);
#pragma unroll
        for (int d0 = 0; d0 < 4; ++d0) s = __builtin_amdgcn_mfma_f32_32x32x16_bf16(kf[d0], qf[d0], s, 0, 0, 0);
        __builtin_amdgcn_sched_barrier(0);
        v4u p0, p1;
#define BA_PKN(a_, b_) __builtin_bit_cast(unsigned, __builtin_amdgcn_cvt_pknorm_u16((a_), (b_)))
        p0.x = BA_PKN(s[0], s[1]); p0.y = BA_PKN(s[2], s[3]); p0.z = BA_PKN(s[4], s[5]); p0.w = BA_PKN(s[6], s[7]);
        p1.x = BA_PKN(s[8], s[9]); p1.y = BA_PKN(s[10], s[11]); p1.z = BA_PKN(s[12], s[13]); p1.w = BA_PKN(s[14], s[15]);
#undef BA_PKN
        orw |= (p0.x | p0.y | p0.z) | (p0.w | p1.x | p1.y) | (p1.z | p1.w);
        const bf16x8 pk0 = __builtin_bit_cast(bf16x8, p0), pk1 = __builtin_bit_cast(bf16x8, p1);
        lsum = __builtin_amdgcn_mfma_f32_16x16x32_bf16(onesA, pk0, lsum, 0, 0, 0); lsum = __builtin_amdgcn_mfma_f32_16x16x32_bf16(onesA, pk1, lsum, 0, 0, 0);
        o0 = __builtin_amdgcn_mfma_f32_32x32x16_bf16(BA_VF(0), pk0, o0, 0, 0, 0); o1 = __builtin_amdgcn_mfma_f32_32x32x16_bf16(BA_VF(2), pk0, o1, 0, 0, 0);
        o0 = __builtin_amdgcn_mfma_f32_32x32x16_bf16(BA_VF(4), pk1, o0, 0, 0, 0); o1 = __builtin_amdgcn_mfma_f32_32x32x16_bf16(BA_VF(6), pk1, o1, 0, 0, 0);
    }
#undef BA_VF
#undef BA_TR
#undef BA_LOAD
}
__device__ __forceinline__ void band_store(const f32x16& o0, const f32x16& o1, float l, unsigned char* orow  , int lane) {
    const float lt = xhalf_sum(l), inv = attn_body::OSCALE / lt; const int hh = lane >> 5;
    unsigned e[8];
#pragma unroll
    for (int g = 0; g < 4; ++g) {
        const unsigned w0 = pg8::pk4_fp8(pg8::clamp448(o0[4 * g] * inv), pg8::clamp448(o0[4 * g + 1] * inv), pg8::clamp448(o0[4 * g + 2] * inv), pg8::clamp448(o0[4 * g + 3] * inv));
        const unsigned w1 = pg8::pk4_fp8(pg8::clamp448(o1[4 * g] * inv), pg8::clamp448(o1[4 * g + 1] * inv), pg8::clamp448(o1[4 * g + 2] * inv), pg8::clamp448(o1[4 * g + 3] * inv));
        const auto rr = __builtin_amdgcn_permlane32_swap(w0, w1, false, false);
        e[2 * g] = rr[0]; e[2 * g + 1] = rr[1]; }
    *(v4u*)(orow + 32 * hh) = (v4u){e[0], e[1], e[2], e[3]}; *(v4u*)(orow + 32 * hh + 16) = (v4u){e[4], e[5], e[6], e[7]};
}
constexpr int TA_LEN = 1280, TA_OFF = 512, TC_LEN = 384, TC_OFF = 32, BAND_TAB_BYTES = 16384, BAND_VST_OFF = 16384;
__device__ __forceinline__ void band_state_store(const f32x16& o0, const f32x16& o1, float m, float l, float* st, float* ml, int lane) {
    const float lt = xhalf_sum(l); const int hh = lane >> 5;
    bf16* sb = (bf16*)st;
#pragma unroll
    for (int g = 0; g < 4; ++g) {
        const auto rx = __builtin_amdgcn_permlane32_swap(pkbf(o0[4 * g], o0[4 * g + 1]), pkbf(o1[4 * g], o1[4 * g + 1]), false, false);
        const auto ry = __builtin_amdgcn_permlane32_swap(pkbf(o0[4 * g + 2], o0[4 * g + 3]), pkbf(o1[4 * g + 2], o1[4 * g + 3]), false, false);
        *(v4u*)(sb + 32 * hh + 8 * g) = (v4u){rx[0], ry[0], rx[1], ry[1]}; }
    if (hh == 0) *(f32x2*)ml = (f32x2){m, lt};
}
__device__ __forceinline__ void band_state_load(f32x16& o0, f32x16& o1, float& m, float& l, const float* st, const float* ml, int lane) {
    const int hh = lane >> 5;
    const bf16* sb = (const bf16*)st;
#pragma unroll
    for (int g = 0; g < 4; ++g) { const v4u q = *(const v4u*)(sb + 32 * hh + 8 * g);
        const auto rx = __builtin_amdgcn_permlane32_swap(q.x, q.z, false, false), ry = __builtin_amdgcn_permlane32_swap(q.y, q.w, false, false);
        const v2u a = {rx[0], ry[0]}, b = {rx[1], ry[1]};
        o0[4 * g] = bf_lo(a.x); o0[4 * g + 1] = bf_hi(a.x); o0[4 * g + 2] = bf_lo(a.y); o0[4 * g + 3] = bf_hi(a.y); o1[4 * g] = bf_lo(b.x); o1[4 * g + 1] = bf_hi(b.x); o1[4 * g + 2] = bf_lo(b.y); o1[4 * g + 3] = bf_hi(b.y); }
    const f32x2 v = *(const f32x2*)ml; m = v.x; l = (hh == 0) ? v.y : 0.f;
}
__device__ __forceinline__ void mixer_a_phase(const bf16* AQ, const bf16* AK, const bf16* AV  , bf16* O, float* ST, float* ML, const float* rel_bias, LAS unsigned char* lds, int G, int blk, int tid, int lane, int wave) {
    LAS float* tab = (LAS float*)lds; LAS unsigned char* vst = lds + BAND_VST_OFF + wave * 8192;
    constexpr float M_FAST = 127.0f;
    int cur_h = -1;
    for (int u = blk; u < 512; u += G) {
        const int h = u & 7, v = u >> 3, b = v >> 4, a = v & 15;
        if (h != cur_h) {
            __syncthreads();
            for (int idx = tid; idx < 3 * TA_LEN; idx += NWAVES * 64) { const int br = idx / TA_LEN, i = idx % TA_LEN - TA_OFF, dil = br == 0 ? 1 : (br == 1 ? 4 : 16);
                tab[idx] = (i >= 0 && i <= 128) ? (rel_bias[h * 32 + t5_bucket((i - 64) * dil)] * LOG2E + 64.0f) * KAPPA : -1.0f; }
            __syncthreads(); cur_h = h;
        }
        const int i5 = lane & 31, hh = lane >> 5;
        const size_t tb0 = (size_t)b * SEQ;
        const bf16* Kb = AK + tb0 * 512 + h * 64; const bf16* Vb = AV + tb0 * 512 + h * 64;
        bf16x8 qn[4];
        { const bf16* qp = AQ + (tb0 + 512 * a + 32 * wave + i5) * 512 + h * 64 + 8 * hh;
#pragma unroll
          for (int d0 = 0; d0 < 4; ++d0) qn[d0] = *(const bf16x8*)(qp + 16 * d0); }
#pragma unroll 1
        for (int tile = wave; tile < 16; tile += NWAVES) {
            const int q0 = 512 * a + 32 * tile, tq = q0 + i5;
            bf16x8 qf[4];
#pragma unroll
            for (int d0 = 0; d0 < 4; ++d0) qf[d0] = qn[d0];
            { const bool more = tile + NWAVES < 16; const bf16* qp = more ? AQ + (tb0 + tq + 32 * NWAVES) * 512 + h * 64 + 8 * hh : AQ + (tb0 + 512 * a + 16 * i5 + wave) * 512 + h * 64 + 8 * hh;
#pragma unroll
              for (int d0 = 0; d0 < 4; ++d0) qn[d0] = *(const bf16x8*)(qp + 16 * d0); }
            f32x16 o0 = {}, o1 = {}; f32x4 lsum = {0.f, 0.f, 0.f, 0.f}; unsigned orw = 0u; float m = M_FAST, l;
            band_branch_fast(o0, o1, lsum, orw, qf, Kb, 512, Vb, 512, 1, 0, SEQ, q0 - 64, 5, tab, -tq + 64 + TA_OFF + 8 * hh, vst, lane);
            { const float la = __shfl(lsum[0], i5 & 15), lb = __shfl(lsum[1], i5 & 15); const float lt = (i5 & 16) ? lb : la;
              l = (hh == 0) ? lt : 0.0f;
              if (__builtin_expect(__any(((orw & 0xC000C000u) != 0u) || !(lt > 1.0e-30f)), 0)) {
                  o0 = f32x16{}; o1 = f32x16{}; m = NEGBIG; l = 0.f;
                  band_branch(o0, o1, m, l, qf, Kb, 512, Vb, 512, 1, 0, SEQ, q0 - 64, 5, tab, -tq + 64 + TA_OFF + 8 * hh, vst, lane, KAPPA_INV); } }
            band_state_store(o0, o1, m, l, ST + ((tb0 + tq) * 8 + h) * 64, ML + ((tb0 + tq) * 8 + h) * 2, lane);
        }
        asm volatile("s_waitcnt vmcnt(0)" ::: "memory");
        __syncthreads();
#pragma unroll 1
        for (int r = wave; r < 16; r += NWAVES) {
            const int tq = 512 * a + 16 * i5 + r;
            bf16x8 qf[4];
#pragma unroll
            for (int d0 = 0; d0 < 4; ++d0) qf[d0] = qn[d0];
            if (r + NWAVES < 16) { const bf16* qp = AQ + (tb0 + tq + NWAVES) * 512 + h * 64 + 8 * hh;
#pragma unroll
              for (int d0 = 0; d0 < 4; ++d0) qn[d0] = *(const bf16x8*)(qp + 16 * d0); }
            f32x16 o0, o1; float m, l;
            band_state_load(o0, o1, m, l, ST + ((tb0 + tq) * 8 + h) * 64, ML + ((tb0 + tq) * 8 + h) * 2, lane);
            bool exact = __any(m != M_FAST);
            if (__builtin_expect(!exact, 1)) {
                f32x4 lsum = {0.f, 0.f, 0.f, 0.f}; unsigned orw = 0u;
                band_branch_fast(o0, o1, lsum, orw, qf, Kb, 512, Vb, 512, 16, r, 512, 32 * (a - 2), 5, tab + 2 * TA_LEN, -(32 * a + i5) + 64 + TA_OFF + 8 * hh, vst, lane);
                band_branch_fast(o0, o1, lsum, orw, qf, Kb, 512, Vb, 512, 4, r & 3, 2048, 128 * a - 64, 8, tab + TA_LEN, -(128 * a + 4 * i5 + (r >> 2)) + 64 + TA_OFF + 8 * hh, vst, lane);
                const float la = __shfl(lsum[0], i5 & 15), lb = __shfl(lsum[1], i5 & 15); const float lt = (i5 & 16) ? lb : la;
                const float l1 = xhalf_sum(l);
                if (__builtin_expect(__any(((orw & 0xC000C000u) != 0u) || !(l1 + lt > 1.0e-30f)), 0)) { exact = true; band_state_load(o0, o1, m, l, ST + ((tb0 + tq) * 8 + h) * 64, ML + ((tb0 + tq) * 8 + h) * 2, lane); }
                else l = (hh == 0) ? (l1 + lt) : 0.0f;
            }
            if (__builtin_expect(exact, 0)) {
                band_branch(o0, o1, m, l, qf, Kb, 512, Vb, 512, 16, r, 512, 32 * (a - 2), 5, tab + 2 * TA_LEN, -(32 * a + i5) + 64 + TA_OFF + 8 * hh, vst, lane, KAPPA_INV);
                band_branch(o0, o1, m, l, qf, Kb, 512, Vb, 512, 4, r & 3, 2048, 128 * a - 64, 8, tab + TA_LEN, -(128 * a + 4 * i5 + (r >> 2)) + 64 + TA_OFF + 8 * hh, vst, lane, KAPPA_INV);
            }
            band_store(o0, o1, l, (unsigned char*)O + (size_t)(tb0 + tq) * 1024 + h * 64, lane);
        }
    }
}
__device__ __forceinline__ void band_branch_shared(f32x16& o0, f32x16& o1, float& m, float& l, const bf16x8 (&qf)[4],
        const LAS unsigned char* kimg, const LAS unsigned char* vimg, int rw0, int L, int kb_first, int ntiles, const LAS float* tab, int tboff, int lane, float unscale = 1.0f) {
    int kt_lo = 0, kt_hi = ntiles;
    if (kb_first < 0) kt_lo = (-kb_first) >> 5;
    { const int mx = (L - kb_first) >> 5; if (mx < kt_hi) kt_hi = mx; }
    const int i5 = lane & 31, hh = lane >> 5;
    const int pi = (i5 & 0x13) | (((i5 >> 2) & 1) << 3) | (((i5 >> 3) & 1) << 2);
    const LAS unsigned char* trb = vimg + (rw0 + 8 * hh + ((lane & 15) >> 2)) * 128 + (16 * ((lane >> 4) & 1) + 4 * (lane & 3)) * 2;
    const LAS unsigned char* krd = kimg + (rw0 + pi) * 128;
#define BA_TR(off_) __builtin_bit_cast(s16x4, __builtin_amdgcn_ds_read_tr16_b64_v4i16((LAS v4i16_t*)(trb + (off_))))
#define BA_VF(vt, i_) (bf16x8){vt[i_][0], vt[i_][1], vt[i_][2], vt[i_][3], vt[(i_) + 1][0], vt[(i_) + 1][1], vt[(i_) + 1][2], vt[(i_) + 1][3]}
#define BA_FETCH(kf, s, vt, kt_) do { const int tb_ = (kt_) * 4096; \
        _Pragma("unroll") for (int d0 = 0; d0 < 4; ++d0) kf[d0] = *(const LAS bf16x8*)(krd + tb_ + (((2 * d0 + hh) ^ (pi & 7)) * 16)); \
        const LAS float* tp_ = tab + (kb_first + 32 * (kt_) + tboff); \
        _Pragma("unroll") for (int r = 0; r < 16; ++r) s[r] = tp_[(r & 7) + 16 * (r >> 3)]; \
        _Pragma("unroll") for (int i = 0; i < 8; ++i) vt[i] = BA_TR(tb_ + (i >> 2) * 2048 + ((i >> 1) & 1) * 64 + (i & 1) * 512); } while (0)
#define BA_PACK(p0, p1, s) do { p0.x = pkbf(s[0], s[1]); p0.y = pkbf(s[2], s[3]); p0.z = pkbf(s[4], s[5]); p0.w = pkbf(s[6], s[7]); \
        p1.x = pkbf(s[8], s[9]); p1.y = pkbf(s[10], s[11]); p1.z = pkbf(s[12], s[13]); p1.w = pkbf(s[14], s[15]); } while (0)
    int kt = kt_lo;
    for (; kt + 1 < kt_hi; kt += 2) {
        bf16x8 kfa[4], kfb[4]; f32x16 sa, sb; s16x4 vta[8], vtb[8];
        BA_FETCH(kfa, sa, vta, kt); BA_FETCH(kfb, sb, vtb, kt + 1);
        __builtin_amdgcn_sched_barrier(0);
#pragma unroll
        for (int d0 = 0; d0 < 4; ++d0) { sa = __builtin_amdgcn_mfma_f32_32x32x16_bf16(kfa[d0], qf[d0], sa, 0, 0, 0); sb = __builtin_amdgcn_mfma_f32_32x32x16_bf16(kfb[d0], qf[d0], sb, 0, 0, 0); }
        __builtin_amdgcn_sched_barrier(0);
        if (unscale != 1.0f) {
#pragma unroll
            for (int r = 0; r < 16; ++r) { sa[r] *= unscale; sb[r] *= unscale; } }
        float mx = fmaxf(sa[0], sb[0]);
#pragma unroll
        for (int r = 1; r < 16; ++r) mx = fmaxf(mx, fmaxf(sa[r], sb[r]));
        mx = xhalf_max(mx);
        if (__any(mx > m)) {
            const float mn = fmaxf(m, mx), f = __builtin_amdgcn_exp2f(m - mn); m = mn; l *= f;
#pragma unroll
            for (int r = 0; r < 16; ++r) { o0[r] *= f; o1[r] *= f; }
        }
        float ps = 0.f;
#pragma unroll
        for (int r = 0; r < 16; ++r) { sa[r] = __builtin_amdgcn_exp2f(sa[r] - m); sb[r] = __builtin_amdgcn_exp2f(sb[r] - m); ps += sa[r] + sb[r]; }
        l += ps;
        v4u pa0, pa1, pb0, pb1; BA_PACK(pa0, pa1, sa); BA_PACK(pb0, pb1, sb);
        const bf16x8 ka0 = __builtin_bit_cast(bf16x8, pa0), ka1 = __builtin_bit_cast(bf16x8, pa1), kb0 = __builtin_bit_cast(bf16x8, pb0), kb1 = __builtin_bit_cast(bf16x8, pb1);
        o0 = __builtin_amdgcn_mfma_f32_32x32x16_bf16(BA_VF(vta, 0), ka0, o0, 0, 0, 0); o1 = __builtin_amdgcn_mfma_f32_32x32x16_bf16(BA_VF(vta, 2), ka0, o1, 0, 0, 0);
        o0 = __builtin_amdgcn_mfma_f32_32x32x16_bf16(BA_VF(vta, 4), ka1, o0, 0, 0, 0); o1 = __builtin_amdgcn_mfma_f32_32x32x16_bf16(BA_VF(vta, 6), ka1, o1, 0, 0, 0);
        o0 = __builtin_amdgcn_mfma_f32_32x32x16_bf16(BA_VF(vtb, 0), kb0, o0, 0, 0, 0); o1 = __builtin_amdgcn_mfma_f32_32x32x16_bf16(BA_VF(vtb, 2), kb0, o1, 0, 0, 0);
        o0 = __builtin_amdgcn_mfma_f32_32x32x16_bf16(BA_VF(vtb, 4), kb1, o0, 0, 0, 0); o1 = __builtin_amdgcn_mfma_f32_32x32x16_bf16(BA_VF(vtb, 6), kb1, o1, 0, 0, 0);
    }
    if (kt < kt_hi) {
        bf16x8 kfa[4]; f32x16 sa; s16x4 vta[8];
        BA_FETCH(kfa, sa, vta, kt);
        __builtin_amdgcn_sched_barrier(0);
#pragma unroll
        for (int d0 = 0; d0 < 4; ++d0) sa = __builtin_amdgcn_mfma_f32_32x32x16_bf16(kfa[d0], qf[d0], sa, 0, 0, 0);
        __builtin_amdgcn_sched_barrier(0);
        if (unscale != 1.0f) {
#pragma unroll
            for (int r = 0; r < 16; ++r) sa[r] *= unscale; }
        float mx = fmaxf(sa[0], sa[1]);
#pragma unroll
        for (int r = 2; r < 16; ++r) mx = fmaxf(mx, sa[r]);
        mx = xhalf_max(mx);
        if (__any(mx > m)) {
            const float mn = fmaxf(m, mx), f = __builtin_amdgcn_exp2f(m - mn); m = mn; l *= f;
#pragma unroll
            for (int r = 0; r < 16; ++r) { o0[r] *= f; o1[r] *= f; }
        }
        float ps = 0.f;
#pragma unroll
        for (int r = 0; r < 16; ++r) { sa[r] = __builtin_amdgcn_exp2f(sa[r] - m); ps += sa[r]; }
        l += ps;
        v4u pa0, pa1; BA_PACK(pa0, pa1, sa);
        const bf16x8 ka0 = __builtin_bit_cast(bf16x8, pa0), ka1 = __builtin_bit_cast(bf16x8, pa1);
        o0 = __builtin_amdgcn_mfma_f32_32x32x16_bf16(BA_VF(vta, 0), ka0, o0, 0, 0, 0); o1 = __builtin_amdgcn_mfma_f32_32x32x16_bf16(BA_VF(vta, 2), ka0, o1, 0, 0, 0);
        o0 = __builtin_amdgcn_mfma_f32_32x32x16_bf16(BA_VF(vta, 4), ka1, o0, 0, 0, 0); o1 = __builtin_amdgcn_mfma_f32_32x32x16_bf16(BA_VF(vta, 6), ka1, o1, 0, 0, 0);
    }
#undef BA_PACK
#undef BA_FETCH
#undef BA_VF
#undef BA_TR
}
__device__ __forceinline__ void band_branch_shared_fast(f32x16& o0, f32x16& o1, f32x4& lsum, unsigned& orw, const bf16x8 (&qf)[4],
        const LAS unsigned char* kimg, const LAS unsigned char* vimg, int rw0, int L, int kb_first, int ntiles, const LAS float* tab, int tboff, int lane) {
    int kt_lo = 0, kt_hi = ntiles;
    if (kb_first < 0) kt_lo = (-kb_first) >> 5;
    { const int mx = (L - kb_first) >> 5; if (mx < kt_hi) kt_hi = mx; }
    const int i5 = lane & 31, hh = lane >> 5;
    const int pi = (i5 & 0x13) | (((i5 >> 2) & 1) << 3) | (((i5 >> 3) & 1) << 2);
    const LAS unsigned char* trb = vimg + (rw0 + 8 * hh + ((lane & 15) >> 2)) * 128 + (16 * ((lane >> 4) & 1) + 4 * (lane & 3)) * 2;
    const LAS unsigned char* krd = kimg + (rw0 + pi) * 128;
    { unsigned a_ = (unsigned)(size_t)trb, b_ = (unsigned)(size_t)krd; asm volatile("" : "+v"(a_), "+v"(b_)); trb = (const LAS unsigned char*)(size_t)a_; krd = (const LAS unsigned char*)(size_t)b_; }
    const unsigned one2 = ((lane & 15) == ((lane >> 4) & 1)) ? 0x3F803F80u : 0u;
    const bf16x8 onesA = __builtin_bit_cast(bf16x8, (v4u){one2, one2, one2, one2});
#define BA_TR(off_) __builtin_bit_cast(s16x4, __builtin_amdgcn_ds_read_tr16_b64_v4i16((LAS v4i16_t*)(trb + (off_))))
#define BA_VF(vt, i_) (bf16x8){vt[i_][0], vt[i_][1], vt[i_][2], vt[i_][3], vt[(i_) + 1][0], vt[(i_) + 1][1], vt[(i_) + 1][2], vt[(i_) + 1][3]}
#define BA_FETCH(kf, s, vt, kt_) do { const int tb_ = (kt_) * 4096; \
        _Pragma("unroll") for (int d0 = 0; d0 < 4; ++d0) kf[d0] = *(const LAS bf16x8*)(krd + tb_ + (((2 * d0 + hh) ^ (pi & 7)) * 16)); \
        const LAS float* tp_ = tab + (kb_first + 32 * (kt_) + tboff); \
        _Pragma("unroll") for (int r = 0; r < 16; ++r) s[r] = tp_[(r & 7) + 16 * (r >> 3)]; \
        _Pragma("unroll") for (int i = 0; i < 8; ++i) vt[i] = BA_TR(tb_ + (i >> 2) * 2048 + ((i >> 1) & 1) * 64 + (i & 1) * 512); } while (0)
#define BA_PKN(a_, b_) __builtin_bit_cast(unsigned, __builtin_amdgcn_cvt_pknorm_u16((a_), (b_)))
#define BA_PACKN(p0, p1, s) do { p0.x = BA_PKN(s[0], s[1]); p0.y = BA_PKN(s[2], s[3]); p0.z = BA_PKN(s[4], s[5]); p0.w = BA_PKN(s[6], s[7]); \
        p1.x = BA_PKN(s[8], s[9]); p1.y = BA_PKN(s[10], s[11]); p1.z = BA_PKN(s[12], s[13]); p1.w = BA_PKN(s[14], s[15]); \
        orw |= (p0.x | p0.y | p0.z) | (p0.w | p1.x | p1.y) | (p1.z | p1.w); } while (0)
#define BA_TILE_PV(vt, k0, k1) do { lsum = __builtin_amdgcn_mfma_f32_16x16x32_bf16(onesA, k0, lsum, 0, 0, 0); lsum = __builtin_amdgcn_mfma_f32_16x16x32_bf16(onesA, k1, lsum, 0, 0, 0); \
        o0 = __builtin_amdgcn_mfma_f32_32x32x16_bf16(BA_VF(vt, 0), k0, o0, 0, 0, 0); o1 = __builtin_amdgcn_mfma_f32_32x32x16_bf16(BA_VF(vt, 2), k0, o1, 0, 0, 0); \
        o0 = __builtin_amdgcn_mfma_f32_32x32x16_bf16(BA_VF(vt, 4), k1, o0, 0, 0, 0); o1 = __builtin_amdgcn_mfma_f32_32x32x16_bf16(BA_VF(vt, 6), k1, o1, 0, 0, 0); } while (0)
    int kt = kt_lo;
    for (; kt + 1 < kt_hi; kt += 2) {
        bf16x8 kfa[4], kfb[4]; f32x16 sa, sb; s16x4 vta[8], vtb[8];
        BA_FETCH(kfa, sa, vta, kt); BA_FETCH(kfb, sb, vtb, kt + 1);
        __builtin_amdgcn_sched_barrier(0);
#pragma unroll
        for (int d0 = 0; d0 < 4; ++d0) { sa = __builtin_amdgcn_mfma_f32_32x32x16_bf16(kfa[d0], qf[d0], sa, 0, 0, 0); sb = __builtin_amdgcn_mfma_f32_32x32x16_bf16(kfb[d0], qf[d0], sb, 0, 0, 0); }
        __builtin_amdgcn_sched_barrier(0);
        v4u pa0, pa1, pb0, pb1; BA_PACKN(pa0, pa1, sa); BA_PACKN(pb0, pb1, sb);
        const bf16x8 ka0 = __builtin_bit_cast(bf16x8, pa0), ka1 = __builtin_bit_cast(bf16x8, pa1), kb0 = __builtin_bit_cast(bf16x8, pb0), kb1 = __builtin_bit_cast(bf16x8, pb1);
        BA_TILE_PV(vta, ka0, ka1); BA_TILE_PV(vtb, kb0, kb1);
    }
    if (kt < kt_hi) {
        bf16x8 kfa[4]; f32x16 sa; s16x4 vta[8];
        BA_FETCH(kfa, sa, vta, kt);
        __builtin_amdgcn_sched_barrier(0);
#pragma unroll
        for (int d0 = 0; d0 < 4; ++d0) sa = __builtin_amdgcn_mfma_f32_32x32x16_bf16(kfa[d0], qf[d0], sa, 0, 0, 0);
        __builtin_amdgcn_sched_barrier(0);
        v4u pa0, pa1; BA_PACKN(pa0, pa1, sa);
        const bf16x8 ka0 = __builtin_bit_cast(bf16x8, pa0), ka1 = __builtin_bit_cast(bf16x8, pa1);
        BA_TILE_PV(vta, ka0, ka1);
    }
#undef BA_TILE_PV
#undef BA_PACKN
#undef BA_PKN
#undef BA_FETCH
#undef BA_VF
#undef BA_TR
}
__device__ __forceinline__ void mixer_c_shared(const bf16* CQ, const bf16* CK, const bf16* CV  , bf16* O, const float* rel_bias, const float* sink, LAS unsigned char* lds, int G, int blk, int tid, int lane, int wave) {
    LAS float* tab4 = (LAS float*)lds; LAS unsigned char* kimg = lds + 6144; LAS unsigned char* vimg = lds + 6144 + 65536;
    static_assert(4 * TC_LEN * 4 <= 6144 && 6144 + 2 * 65536 <= SCR_BYTES, "mixer C LDS map");
    for (int su = blk; su < 512; su += G) {
        const int kvh = su & 3, v = su >> 2, b = v >> 5, q0 = 256 * (v & 31), w0 = q0 - 128;
        const size_t tb0 = (size_t)b * SEQ;
        const int i5 = lane & 31, hh = lane >> 5, q0w = q0 + 32 * wave, tq = q0w + i5;
        const bf16* qp = CQ + (tb0 + tq) * 1024 + (4 * kvh) * 64 + 8 * hh;
        bf16x8 qn[4];
#pragma unroll
        for (int d0 = 0; d0 < 4; ++d0) qn[d0] = *(const bf16x8*)(qp + 16 * d0);
        __syncthreads();
        for (int idx = tid; idx < TC_LEN; idx += NWAVES * 64) { const int i = idx - TC_OFF; const bool in = (i >= 0 && i <= 256); const int bk = in ? t5_bucket(i - 128) : 0;
#pragma unroll
            for (int j = 0; j < 4; ++j) tab4[j * TC_LEN + idx] = in ? (rel_bias[(4 * kvh + j) * 32 + bk] * LOG2E + 64.0f) * KAPPA : -1.0f; }
#pragma unroll
        for (int half = 0; half < 2; ++half) {
            v4u kv[4], vv[4];
#pragma unroll
            for (int i = 0; i < 4; ++i) { const int c = tid + 512 * (4 * half + i), rw = c >> 3, ch = c & 7, key = w0 + rw; const bool ok = key >= 0 && key < SEQ; const size_t ro = (tb0 + (ok ? key : 0)) * 256 + kvh * 64 + 8 * ch;
                kv[i] = *(const v4u*)(CK + ro); vv[i] = *(const v4u*)(CV + ro); }
#pragma unroll
            for (int i = 0; i < 4; ++i) { const int c = tid + 512 * (4 * half + i), rw = c >> 3, ch = c & 7;
                *(LAS v4u*)(kimg + rw * 128 + ((ch ^ (rw & 7)) * 16)) = kv[i]; *(LAS v4u*)(vimg + rw * 128 + ch * 16) = vv[i]; }
        }
        __syncthreads();
#pragma unroll 1
        for (int j = 0; j < 4; ++j) {
            const int h = 4 * kvh + j; const LAS float* tab = tab4 + j * TC_LEN;
            bf16x8 qf[4];
#pragma unroll
            for (int d0 = 0; d0 < 4; ++d0) qf[d0] = qn[d0];
            if (j < 3) {
#pragma unroll
                for (int d0 = 0; d0 < 4; ++d0) qn[d0] = *(const bf16x8*)(qp + 64 * (j + 1) + 16 * d0); }
            f32x16 o0 = {}, o1 = {}; f32x4 lsum = {0.f, 0.f, 0.f, 0.f}; unsigned orw = 0u; float l;
            band_branch_shared_fast(o0, o1, lsum, orw, qf, kimg, vimg, 32 * wave, SEQ, q0w - 128, 9, tab, -tq + 128 + TC_OFF + 8 * hh, lane);
            {
              const float xs = fminf(fmaxf((sink[h] * LOG2E + 64.0f) * 128.0f, 0.0f), 32767.0f); const float ps = __uint_as_float(((unsigned)__float2int_rn(xs)) << 16);
              const float la = __shfl(lsum[0], i5 & 15), lb = __shfl(lsum[1], i5 & 15); const float lt = ((i5 & 16) ? lb : la) + ps;
              l = (hh == 0) ? lt : 0.0f;
              const bool bad = ((orw & 0xC000C000u) != 0u) || !(lt > 1.0e-30f) || (sink[h] * LOG2E >= 63.0f);
              if (__builtin_expect(__any(bad), 0)) {
                  o0 = f32x16{}; o1 = f32x16{}; float m = sink[h] * LOG2E + 64.0f; l = (hh == 0) ? 1.0f : 0.0f;
                  band_branch_shared(o0, o1, m, l, qf, kimg, vimg, 32 * wave, SEQ, q0w - 128, 9, tab, -tq + 128 + TC_OFF + 8 * hh, lane, KAPPA_INV);
              } }
            band_store(o0, o1, l, (unsigned char*)O + (size_t)(tb0 + tq) * 1024 + h * 64, lane);
        }
    }
}
__device__ __forceinline__ void mixer_c_phase(const bf16* CQ, const bf16* CK, const bf16* CV  , bf16* O, const float* rel_bias, const float* sink, LAS unsigned char* lds, int G, int blk, int tid, int lane, int wave) {
    LAS float* tab = (LAS float*)lds; LAS unsigned char* vst = lds + BAND_VST_OFF + wave * 8192;
    int cur_h = -1;
    for (int u = blk; u < 2048; u += G) {
        const int h = u & 15, v = u >> 4, b = v >> 5, q0 = 256 * (v & 31) + 32 * wave;
        if (h != cur_h) {
            __syncthreads();
            for (int idx = tid; idx < TC_LEN; idx += NWAVES * 64) { const int i = idx - TC_OFF; tab[idx] = (i >= 0 && i <= 256) ? rel_bias[h * 32 + t5_bucket(i - 128)] * LOG2E : NEGBIG; }
            __syncthreads(); cur_h = h;
        }
        const int i5 = lane & 31, hh = lane >> 5;
        const size_t tb0 = (size_t)b * SEQ;
        const int tq = q0 + i5;
        const bf16* qp = CQ + (tb0 + tq) * 1024 + h * 64 + 8 * hh;
        bf16x8 qf[4];
#pragma unroll
        for (int d0 = 0; d0 < 4; ++d0) qf[d0] = *(const bf16x8*)(qp + 16 * d0);
        f32x16 o0 = {}, o1 = {}; float m = sink[h] * LOG2E, l = (hh == 0) ? 1.0f : 0.0f;
        const bf16* Kb = CK + tb0 * 256 + (h >> 2) * 64; const bf16* Vb = CV + tb0 * 256 + (h >> 2) * 64;
        band_branch(o0, o1, m, l, qf, Kb, 256, Vb, 256, 1, 0, SEQ, q0 - 128, 9, tab, -tq + 128 + TC_OFF + 8 * hh, vst, lane);
        band_store(o0, o1, l, (unsigned char*)O + (size_t)(tb0 + tq) * 1024 + h * 64, lane);
    }
}

struct Args { const float* in[25]; float* out; unsigned char* ws; int ph_lo, ph_hi; };
__global__ void __launch_bounds__(NWAVES * 64, 2) enc_fwd(Args args) {
    extern __shared__ __attribute__((aligned(16))) unsigned char lds_raw[];
    LAS unsigned char* lds = (LAS unsigned char*)lds_raw;
    volatile LAS unsigned* MISC = (volatile LAS unsigned*)(lds + MISC_OFF);
    const int tid_k = threadIdx.x, wave = __builtin_amdgcn_readfirstlane(tid_k >> 6);
    int tid = tid_k, lane = tid_k & 63;
#define PHASE_IDS() do { int t_ = tid_k; asm volatile("" : "+v"(t_)); tid = t_; lane = t_ & 63; } while (0)
    const int G = gridDim.x, blk = blockIdx.x;
    const int vcu = (G % 8 == 0) ? (blk % 8) * (G / 8) + blk / 8 : blk;
    const int gw = vcu * NWAVES + wave, NGW = G * NWAVES;
    unsigned char* ws = args.ws;
    gu32* ctl = (gu32*)(ws + WS_CTL);
    for (int u = tid_k; u < (LDS_BYTES - LDSCTL_OFF) / 4; u += NWAVES * 64) ((LAS unsigned*)(lds + LDSCTL_OFF))[u] = 0u;
    __syncthreads();
#if MK_SINGLE
    XcdBarrier bar = xcd_barrier_post((unsigned*)(ctl + CW_BAR), MISC + 8);
#define GRID_BAR() xcd_barrier(bar)
    const XcdBarrier* bar_ptr = &bar;
#define xcd_barrier_wait_if_single(p) xcd_barrier_wait(*(p))
#else
#define GRID_BAR() do {} while (0)
    const void* bar_ptr = nullptr;
#define xcd_barrier_wait_if_single(p) ((void)(p))
#endif
    const int lo = args.ph_lo, hi = args.ph_hi; bool rt_ready = false;
#define IN(k) (lo <= (k) && (k) < hi)
#define REP(k) for (int rep_ = 0; rep_ < ((((PROBE_MASK) >> (k)) & 1) ? 2 : 1); ++rep_)
#define SEAM(k) do { if (IN(k) && IN((k) + 1)) GRID_BAR(); } while (0)
    const float* x = args.in[0]; const float* rel_bias = args.in[1]; float* out = args.out;
    bf16* XR = (bf16*)(ws + WS_XR); bf16* WIN0 = (bf16*)(ws + WS_WIN0); bf16* WOUT0 = (bf16*)(ws + WS_WOUT0); bf16* WIN1 = (bf16*)(ws + WS_WIN1); bf16* WOUT1 = (bf16*)(ws + WS_WOUT1);
    unsigned char* WGU0 = ws + WS_WGU0; unsigned char* WDN0 = ws + WS_WDN0; unsigned char* WGU1 = ws + WS_WGU1; unsigned char* WDN1 = ws + WS_WDN1; bf16* XN = (bf16*)(ws + WS_XN); unsigned char* XN8 = ws + WS_XN8;
    float* AFF = (float*)(ws + WS_AFF); int* SEL = (int*)(ws + WS_SEL); int* IDX = (int*)(ws + WS_IDX); float* GATE = (float*)(ws + WS_GATE);
    f32x2* ROPE = (f32x2*)(ws + WS_ROPE);
    bf16* AQ = (bf16*)(ws + WS_AQ); bf16* AK = (bf16*)(ws + WS_AK); bf16* AV = (bf16*)(ws + WS_AV); bf16* BQ = (bf16*)(ws + WS_BQ); bf16* BK = (bf16*)(ws + WS_BK); bf16* BV = (bf16*)(ws + WS_BV);
    bf16* CQ = (bf16*)(ws + WS_CQ); bf16* CK = (bf16*)(ws + WS_CK); bf16* CV = (bf16*)(ws + WS_CV); bf16* OB = (bf16*)(ws + WS_O);
    unsigned char* XS = ws + WS_XS; unsigned char* ACT = ws + WS_ACT; unsigned char* YB = ws + WS_Y;
    LAS float* scr = (LAS float*)(lds + wave * 16640);

    if (IN(0)) REP(0) { PHASE_IDS(); if (rep_) __syncthreads();
        cvt_dense8(args.in[3], DM, L0_IN, (unsigned char*)WIN0, scr, gw, NGW, lane); cvt_dense8(args.in[8], DM, DM, (unsigned char*)WOUT0, scr, gw, NGW, lane);
        cvt_dense8(args.in[15], DM, L1_IN, (unsigned char*)WIN1, scr, gw, NGW, lane); cvt_dense8(args.in[19], DM, DM, (unsigned char*)WOUT1, scr, gw, NGW, lane);
        if (G != 256) { cvt_moe(args.in[11], args.in[12], args.in[13], WGU0, WDN0, scr, gw, NGW, lane); cvt_moe(args.in[22], args.in[23], args.in[24], WGU1, WDN1, scr, gw, NGW, lane); }
        if (blk == 0 && tid < 16) rope_table(ROPE, tid);
        for (int row = 2 * gw; row < NTOK; row += 2 * NGW) rms_row2_to_fp8(x + (size_t)row * DM, args.in[2], (unsigned char*)XN + (size_t)row * DM, lane);
    }
#if MK_SINGLE
    if (IN(0) && IN(1)) { xcd_barrier_arrive(bar); if (!(G == 256 && blk >= G_P1)) xcd_barrier_wait(bar); }
#endif
    if (IN(1)) REP(1) { PHASE_IDS(); if (rep_) __syncthreads();
        const int Gg = (G == 256) ? G_P1 : G;
        if (blk < Gg) {
            pg8::Gemm g{XN, WIN0, NTOK, L0_IN, DM / 2}; pg8::StaticOrder S; S.init(NTOK, L0_IN, Gg, blk);
            pg8::EpiHeads0 E{AQ, AK, AV, BQ, BK, BV, args.in[4], args.in[5], args.in[6], args.in[7], (const pg8::f32x2e*)ROPE, QSCALE, QSCALE * KAPPA};
            pg8::gemm_phase<pg8::EpiHeads0, pg8::StaticOrder, PG8_ALIGN, PG8_SP2, true>(lds, g, S, E);
        } else {
            const int ncw = G - Gg, cw = ((ncw % 8) == 0 && (Gg % 8) == 0) ? (blk % 8) * (ncw / 8) + (blk - Gg) / 8 : blk - Gg;
            const int gwl = cw * NWAVES + wave, ngwl = ncw * NWAVES;
            const CvtSrc A{args.in[11], args.in[12], args.in[13], WGU0, WDN0, 0, 3 * 2048}, B{args.in[22], args.in[23], args.in[24], WGU1, WDN1, CVT1_LATE, 3 * 2048 - CVT1_LATE};
            cvt_moe_pipe2(A, B, scr, gwl, ngwl, lane);
#if MK_SINGLE
            if (IN(0) && G == 256) xcd_barrier_wait(bar);
#endif
        }
    }
    SEAM(1);
    if (IN(3)) { PHASE_IDS();
        const attn_body::AttnTensors AT{(const unsigned char*)BQ, (const unsigned char*)BK, (const unsigned char*)BV, (unsigned char*)OB + 512};
        REP(3) attn_body::attn_phase<4>((char*)lds_raw, AT, G, blk);
        REP(21) mixer_a_phase(AQ, AK, AV, OB, (float*)(ws + WS_ST), (float*)(ws + WS_ML), rel_bias, lds, G, blk, tid, lane, wave);
    }
    SEAM(3);
    if (IN(4)) REP(4) { PHASE_IDS(); if (rep_) __syncthreads();
        pg8::Gemm g{OB, WOUT0, NTOK, DM, DM / 2}; pg8::StaticOrder S; S.init(NTOK, DM, G, blk);
        pg8::EpiResid<true> E{x, XR, DM};
        pg8::gemm_phase<pg8::EpiResid<true>, pg8::StaticOrder, PG8_ALIGN, PG8_SP2, true, 0x7a7a7a7au>(lds, g, S, E);
    }
    { const bool fused_ = IN(4) && IN(5) && MK_SINGLE;
#if MK_SINGLE
      if (fused_) { xcd_barrier_arrive(bar); norm_router_table(args.in[9], args.in[10], (LAS float*)lds, tid_k); xcd_barrier_wait(bar); }
#endif
      if (!fused_) SEAM(4);
      rt_ready = fused_; }
    if (IN(5)) REP(5) { PHASE_IDS(); } if (IN(5)) REP(5) norm_router_phase(XR, args.in[9], args.in[10], XN8, AFF, (LAS float*)lds, gw, NGW, lane, tid, rt_ready);
#if MK_SINGLE
    if (IN(5) && IN(6)) { xcd_barrier_arrive(bar); if (!(G > 64 && blk >= 64)) xcd_barrier_wait(bar); }
#endif
    if (IN(6)) { PHASE_IDS(); topk_phase(AFF, IDX, GATE, SEL, (LAS unsigned*)lds, G, blk, tid, lane, wave);
        if (G > 64 && blk >= 64) { cvt_moe(args.in[22], args.in[23], args.in[24], WGU1, WDN1, scr, (blk - 64) * NWAVES + wave, (G - 64) * NWAVES, lane, 0, CVT1_P6); if (MK_SINGLE && IN(5)) xcd_barrier_wait_if_single(bar_ptr); }
        else if (G <= 64) { __syncthreads(); cvt_moe(args.in[22], args.in[23], args.in[24], WGU1, WDN1, scr, gw, NGW, lane, 0, CVT1_P6); } }
    SEAM(6);
    if (IN(8)) REP(8) { PHASE_IDS(); if (rep_) __syncthreads();
        LAS unsigned* rowoff = (LAS unsigned*)(lds + pg8::STAGE_BYTES);
        pg8::MoeGateUpOrder S{G, blk, rowoff};
        { pg8::Unit u_; for (int ui = 0; ui < 16 && S.next(ui, u_); ++ui) if (tid < 256) rowoff[ui * 256 + tid] = (unsigned)((((u_.pm >> 2) & 3) * SEQ + IDX[256 * u_.pm + tid]) * DM); }
        __syncthreads();
        pg8::Gemm g{(const bf16*)XN8, (const bf16*)WGU0, NPAIR, 4096, DM / 2};
        pg8::EpiSwiGLU E{ACT, DFF};
        pg8::gemm_phase<pg8::EpiSwiGLU, pg8::MoeGateUpOrder, PG8_ALIGN, PG8_SP2, true>(lds, g, S, E);
    }
    SEAM(8);
    if (IN(9)) REP(9) { PHASE_IDS(); if (rep_) __syncthreads();
        pg8::Gemm g{(const bf16*)ACT, (const bf16*)WDN0, NPAIR, DM, DFF / 2}; pg8::MoeDownOrder S{G, blk};
        pg8::EpiDown E{YB, GATE, DM};
        pg8::gemm_phase<pg8::EpiDown, pg8::MoeDownOrder, PG8_ALIGN, PG8_SP2, true>(lds, g, S, E);
    }
    SEAM(9);
    if (IN(10)) { PHASE_IDS();
        combine_phase(XR, YB, SEL, args.in[14], XN, nullptr, gw, NGW, lane);
    }
    SEAM(10);
    if (IN(11)) REP(11) { PHASE_IDS(); if (rep_) __syncthreads();
        pg8::Gemm g{XN, WIN1, NTOK, L1_IN, DM / 2}; pg8::StaticOrder S; S.init(NTOK, L1_IN, G, blk);
        pg8::EpiHeads1 E{CQ, CK, CV, args.in[16], args.in[17], QSCALE * KAPPA};
        pg8::gemm_phase<pg8::EpiHeads1, pg8::StaticOrder, PG8_ALIGN, PG8_SP2, true>(lds, g, S, E);
    }
    SEAM(11);
    if (IN(13)) { PHASE_IDS(); mixer_c_shared(CQ, CK, CV, OB, rel_bias, args.in[18], lds, G, blk, tid, lane, wave); }
    SEAM(13);
    if (IN(14)) REP(14) { PHASE_IDS(); if (rep_) __syncthreads();
        pg8::Gemm g{OB, WOUT1, NTOK, DM, DM / 2}; pg8::StaticOrder S; S.init(NTOK, DM, G, blk);
        pg8::EpiResid<false> E{XR, XR, DM};
        pg8::gemm_phase<pg8::EpiResid<false>, pg8::StaticOrder, PG8_ALIGN, PG8_SP2, true, 0x7a7a7a7au>(lds, g, S, E);
    }
    { const bool fused_ = IN(14) && IN(15) && MK_SINGLE;
#if MK_SINGLE
      if (fused_) { xcd_barrier_arrive(bar); norm_router_table(args.in[20], args.in[21], (LAS float*)lds, tid_k); xcd_barrier_wait(bar); }
#endif
      if (!fused_) SEAM(14);
      rt_ready = fused_; }
    if (IN(15)) REP(15) { PHASE_IDS(); } if (IN(15)) REP(15) norm_router_phase(XR, args.in[20], args.in[21], XN8, AFF, (LAS float*)lds, gw, NGW, lane, tid, rt_ready);
#if MK_SINGLE
    if (IN(15) && IN(16)) { xcd_barrier_arrive(bar); if (!(G > 64 && blk >= 64)) xcd_barrier_wait(bar); }
#endif
    if (IN(16)) { PHASE_IDS(); topk_phase(AFF, IDX, GATE, SEL, (LAS unsigned*)lds, G, blk, tid, lane, wave);
        if (G > 64 && blk >= 64) { cvt_moe(args.in[22], args.in[23], args.in[24], WGU1, WDN1, scr, (blk - 64) * NWAVES + wave, (G - 64) * NWAVES, lane, CVT1_P6, CVT1_LATE); if (MK_SINGLE && IN(15)) xcd_barrier_wait_if_single(bar_ptr); }
        else if (G <= 64) { __syncthreads(); cvt_moe(args.in[22], args.in[23], args.in[24], WGU1, WDN1, scr, gw, NGW, lane, CVT1_P6, CVT1_LATE); } }
    SEAM(16);
    if (IN(18)) REP(18) { PHASE_IDS(); if (rep_) __syncthreads();
        LAS unsigned* rowoff = (LAS unsigned*)(lds + pg8::STAGE_BYTES);
        pg8::MoeGateUpOrder S{G, blk, rowoff};
        { pg8::Unit u_; for (int ui = 0; ui < 16 && S.next(ui, u_); ++ui) if (tid < 256) rowoff[ui * 256 + tid] = (unsigned)((((u_.pm >> 2) & 3) * SEQ + IDX[256 * u_.pm + tid]) * DM); }
        __syncthreads();
        pg8::Gemm g{(const bf16*)XN8, (const bf16*)WGU1, NPAIR, 4096, DM / 2};
        pg8::EpiSwiGLU E{ACT, DFF};
        pg8::gemm_phase<pg8::EpiSwiGLU, pg8::MoeGateUpOrder, PG8_ALIGN, PG8_SP2, true>(lds, g, S, E);
    }
    SEAM(18);
    if (IN(19)) REP(19) { PHASE_IDS(); if (rep_) __syncthreads();
        pg8::Gemm g{(const bf16*)ACT, (const bf16*)WDN1, NPAIR, DM, DFF / 2}; pg8::MoeDownOrder S{G, blk};
        pg8::EpiDown E{YB, GATE, DM};
        pg8::gemm_phase<pg8::EpiDown, pg8::MoeDownOrder, PG8_ALIGN, PG8_SP2, true>(lds, g, S, E);
    }
    SEAM(19);
    if (IN(20)) { PHASE_IDS(); } if (IN(20)) combine_phase(XR, YB, SEL, nullptr, nullptr, out, gw, NGW, lane);
#undef IN
#undef SEAM
}

extern "C" void kernel_launch(void* const* d_in, const int* in_sizes, int n_in, void* d_out, int out_size, void* d_ws, size_t ws_size, hipStream_t stream) {
    static int grid = 0;
    if (grid == 0) {
        if (n_in != 25 || in_sizes[0] != NTOK * DM || out_size != NTOK * DM || ws_size < WS_END) { fprintf(stderr, "kernel_launch: unexpected shapes / workspace (n_in %d, ws %zu < %zu); nothing launched\n", n_in, ws_size, (size_t)WS_END); grid = -1; return; }
        int dev = 0, cus = 0, per_cu = 0;
        if (hipGetDevice(&dev) != hipSuccess || hipDeviceGetAttribute(&cus, hipDeviceAttributeMultiprocessorCount, dev) != hipSuccess) { grid = -1; return; }
        if (hipFuncSetAttribute((const void*)enc_fwd, hipFuncAttributeMaxDynamicSharedMemorySize, LDS_BYTES) != hipSuccess) { fprintf(stderr, "kernel_launch: hipFuncSetAttribute failed\n"); grid = -1; return; }
        if (hipOccupancyMaxActiveBlocksPerMultiprocessor(&per_cu, (const void*)enc_fwd, NWAVES * 64, LDS_BYTES) != hipSuccess || per_cu < 1) { fprintf(stderr, "kernel_launch: occupancy query says %d blocks per CU\n", per_cu); }
        (void)hipGetLastError();
        grid = cus;
    }
    if (grid < 0) return;
    (void)hipMemsetAsync((char*)d_ws + WS_CTL, 0, CTL_ZERO_BYTES, stream);
    Args a{};
    for (int i = 0; i < 25; ++i) a.in[i] = (const float*)d_in[i];
    a.out = (float*)d_out; a.ws = (unsigned char*)d_ws;
#if MK_SINGLE
    a.ph_lo = 0; a.ph_hi = N_PHASES;
    hipLaunchKernelGGL(enc_fwd, dim3(grid), dim3(NWAVES * 64), LDS_BYTES, stream, a);
#else
    for (int p = 0; p < N_PHASES; ++p) { a.ph_lo = p; a.ph_hi = p + 1; hipLaunchKernelGGL(enc_fwd, dim3(grid), dim3(NWAVES * 64), LDS_BYTES, stream, a);
#ifdef PROBE_PH
        if (p == PROBE_PH) hipLaunchKernelGGL(enc_fwd, dim3(grid), dim3(NWAVES * 64), LDS_BYTES, stream, a);
#endif
    }
#endif
}
```
